# Optimizing an MI355X kernel written in HIP

```python
import math
import numpy as np
import jax
import jax.numpy as jnp
from jax import lax

D_MODEL = 2048
BATCH = 8
SEQ = 2048
DEPTH = 2

GRID_W = 64
CTX_LEN = 256
HEAD_DIM = 128
NA_HEADS = 8
NB_HEADS = 4
WIN_H = 8
WIN_W = 16
D_A = NA_HEADS * HEAD_DIM
QK_B = NB_HEADS * 2 * HEAD_DIM
D_B = NB_HEADS * 2 * HEAD_DIM
KV_COLS = 2 * D_A + QK_B + D_B
Q_A_OFF = KV_COLS
Q_B_OFF = Q_A_OFF + D_A
G_OFF = Q_B_OFF + QK_B
D_IN = G_OFF + 2 * D_MODEL
D_FF = 5632
N_MOD = 9
ROT_PAIRS = HEAD_DIM // 4
ROPE_BASE = 10000.0
Q_BLOCK = 128
EPS = 1e-6
NEG_INF = -1e30
ATTN_SCALE = HEAD_DIM ** -0.5

kernel_name = 'hybrid_natten_diffattn_macaron_dit'


def rmsnorm(x, g):
    x32 = x.astype(jnp.float32)
    y = x32 * lax.rsqrt(jnp.mean(x32 * x32, axis=-1, keepdims=True) + EPS)
    return (y * g.astype(jnp.float32)).astype(x.dtype)


def modulate(h, shift, scale):
    return h * (1.0 + scale) + shift


def swiglu(h, w1, w3, w2):
    return (jax.nn.silu(h @ w1) * (h @ w3)) @ w2


def rope_2d_tables(n_tok):
    t = jnp.arange(n_tok)
    pos = jnp.stack([t // GRID_W, t % GRID_W], axis=-1).astype(jnp.float32)
    inv = jnp.power(ROPE_BASE, -jnp.arange(ROT_PAIRS, dtype=jnp.float32) / ROT_PAIRS)
    ang = pos[:, :, None] * inv
    return jnp.cos(ang), jnp.sin(ang)


def apply_rope_2d(x, cos, sin):
    shp = x.shape
    b, s = shp[:2]
    xr = x.reshape(b, s, -1, 2, 2, ROT_PAIRS)
    x0, x1 = xr[..., 0, :], xr[..., 1, :]
    c = cos[None, :, None].astype(x.dtype)
    sn = sin[None, :, None].astype(x.dtype)
    out = jnp.stack([x0 * c - x1 * sn, x0 * sn + x1 * c], axis=-2)
    return out.reshape(shp)


def split_kv(p):
    b, n = p.shape[:2]
    k_a = p[..., 0:D_A].reshape(b, n, NA_HEADS, HEAD_DIM)
    v_a = p[..., D_A:2 * D_A].reshape(b, n, NA_HEADS, HEAD_DIM)
    k_b = p[..., 2 * D_A:2 * D_A + QK_B].reshape(b, n, NB_HEADS, 2, HEAD_DIM)
    v_b = p[..., 2 * D_A + QK_B:KV_COLS].reshape(b, n, NB_HEADS, 2 * HEAD_DIM)
    return k_a, v_a, k_b, v_b


def split_q_gates(p):
    b, n = p.shape[:2]
    q_a = p[..., Q_A_OFF:Q_B_OFF].reshape(b, n, NA_HEADS, HEAD_DIM)
    q_b = p[..., Q_B_OFF:G_OFF].reshape(b, n, NB_HEADS, 2, HEAD_DIM)
    g_a = jax.nn.sigmoid(p[..., G_OFF:G_OFF + D_MODEL])
    g_b = jax.nn.sigmoid(p[..., G_OFF + D_MODEL:D_IN])
    return q_a, q_b, g_a, g_b


def na_tables(rows):
    kh = min(WIN_H, rows)
    r = np.arange(rows)
    rs = np.clip(r - WIN_H // 2, 0, rows - kh)
    key_rows = rs[:, None] + np.arange(kh)[None, :]
    key_tok = (key_rows[:, :, None] * GRID_W + np.arange(GRID_W)[None, None, :]).reshape(rows, kh * GRID_W)
    col = np.arange(GRID_W)
    cs = np.clip(col - WIN_W // 2, 0, GRID_W - WIN_W)
    col_in = (col[None, :] >= cs[:, None]) & (col[None, :] < cs[:, None] + WIN_W)
    mask = np.tile(col_in, (1, kh))
    dr_idx = key_rows - r[:, None] + (WIN_H - 1)
    dc_idx = np.clip(col[None, :] - col[:, None] + (WIN_W - 1), 0, 2 * WIN_W - 2)
    return kh, key_tok, mask, dr_idx, dc_idx


def neighbourhood_attention(q, k, v, k_c, v_c, rpb):
    b, s = q.shape[:2]
    rows = s // GRID_W
    kh, key_tok, mask, dr_idx, dc_idx = na_tables(rows)
    n_loc = kh * GRID_W
    q_blk = q.reshape(b, rows, GRID_W, NA_HEADS, HEAD_DIM)
    k_g = jnp.take(k, key_tok, axis=1)
    v_g = jnp.take(v, key_tok, axis=1)
    bias = rpb.astype(jnp.float32)[:, dr_idx[:, None, :, None], dc_idx[None, :, None, :]]
    bias = bias.reshape(NA_HEADS, rows, GRID_W, n_loc)
    bias = jnp.where(mask[None, None], bias, NEG_INF)
    s_loc = jnp.einsum('brqhd,brkhd->bhrqk', q_blk, k_g, preferred_element_type=jnp.float32) * ATTN_SCALE + bias[None]
    s_ctx = jnp.einsum('brqhd,blhd->bhrql', q_blk, k_c, preferred_element_type=jnp.float32) * ATTN_SCALE
    p = jax.nn.softmax(jnp.concatenate([s_loc, s_ctx], axis=-1), axis=-1).astype(v.dtype)
    o = (jnp.einsum('bhrqk,brkhd->brqhd', p[..., :n_loc], v_g)
         + jnp.einsum('bhrql,blhd->brqhd', p[..., n_loc:], v_c))
    return o.reshape(b, s, D_A)


def ctx_attention(q_c, k_c, v_c):
    b, n = q_c.shape[:2]
    s = jnp.einsum('blhd,bmhd->bhlm', q_c, k_c, preferred_element_type=jnp.float32) * ATTN_SCALE
    p = jax.nn.softmax(s, axis=-1).astype(v_c.dtype)
    return jnp.einsum('bhlm,bmhd->blhd', p, v_c).reshape(b, n, D_A)


def diff_lambda(lq1, lk1, lq2, lk2, lam_init):
    f = jnp.float32
    return (jnp.exp(jnp.sum(lq1.astype(f) * lk1.astype(f)))
            - jnp.exp(jnp.sum(lq2.astype(f) * lk2.astype(f))) + lam_init)


def diff_attend(q, k, v, lam):
    s = jnp.einsum('bqhtd,bkhtd->bhtqk', q, k, preferred_element_type=jnp.float32) * ATTN_SCALE
    p = jax.nn.softmax(s, axis=-1)
    a = (p[:, :, 0] - lam * p[:, :, 1]).astype(v.dtype)
    return jnp.einsum('bhqk,bkhe->bqhe', a, v)


def diff_attention_latent(q, k_all, v_all, lam):
    b, s = q.shape[:2]
    q_blocks = jnp.moveaxis(q.reshape(b, s // Q_BLOCK, Q_BLOCK, NB_HEADS, 2, HEAD_DIM), 1, 0)
    o = lax.map(lambda qb: diff_attend(qb, k_all, v_all, lam), q_blocks)
    return jnp.moveaxis(o, 0, 1).reshape(b, s, NB_HEADS, 2 * HEAD_DIM)


def diff_post(o, g, lam_init):
    b, n = o.shape[:2]
    return (rmsnorm(o, g) * (1.0 - lam_init)).reshape(b, n, D_B)


def merge_branches(y_a, y_b, g_a, g_b, w_pa, w_pb, w_o):
    return (g_a * (y_a @ w_pa) + g_b * (y_b @ w_pb)) @ w_o


def setup_inputs(seed: int = 0) -> dict:
    key = jax.random.key(seed)
    ks = jax.random.split(key, 26)
    f32 = jnp.float32
    L = DEPTH

    def nrm(k, shape, scale=1.0):
        return jax.random.normal(k, shape, f32) * scale

    def w(k, shape, fan_in, scale=1.0):
        return jax.random.normal(k, shape, f32) * (scale * fan_in ** -0.5)

    def gain(k, shape):
        return 1.0 + 0.05 * jax.random.normal(k, shape, f32)

    return {
        'x': nrm(ks[0], (BATCH, SEQ, D_MODEL)),
        'c': nrm(ks[1], (BATCH, D_MODEL)),
        'ctx': nrm(ks[2], (BATCH, CTX_LEN, D_MODEL)),
        'c_ctx': nrm(ks[3], (D_MODEL,)),
        'ada_w': w(ks[4], (L, D_MODEL, N_MOD * D_MODEL), D_MODEL, 0.5),
        'ada_b': nrm(ks[5], (L, N_MOD * D_MODEL), 0.01),
        'n1_g': gain(ks[6], (L, D_MODEL)),
        'ffn1_w1': w(ks[7], (L, D_MODEL, D_FF), D_MODEL),
        'ffn1_w3': w(ks[8], (L, D_MODEL, D_FF), D_MODEL),
        'ffn1_w2': w(ks[9], (L, D_FF, D_MODEL), D_FF),
        'n2_g': gain(ks[10], (L, D_MODEL)),
        'w_in': w(ks[11], (L, D_MODEL, D_IN), D_MODEL),
        'rpb': nrm(ks[12], (L, NA_HEADS, 2 * WIN_H - 1, 2 * WIN_W - 1), 0.1),
        'lam_q1': nrm(ks[13], (L, HEAD_DIM), 0.1),
        'lam_k1': nrm(ks[14], (L, HEAD_DIM), 0.1),
        'lam_q2': nrm(ks[15], (L, HEAD_DIM), 0.1),
        'lam_k2': nrm(ks[16], (L, HEAD_DIM), 0.1),
        'subln_g': gain(ks[17], (L, 2 * HEAD_DIM)),
        'w_pa': w(ks[18], (L, D_A, D_MODEL), D_A),
        'w_pb': w(ks[19], (L, D_B, D_MODEL), D_B),
        'w_o': w(ks[20], (L, D_MODEL, D_MODEL), D_MODEL),
        'n3_g': gain(ks[21], (L, D_MODEL)),
        'ffn2_w1': w(ks[22], (L, D_MODEL, D_FF), D_MODEL),
        'ffn2_w3': w(ks[23], (L, D_MODEL, D_FF), D_MODEL),
        'ffn2_w2': w(ks[24], (L, D_FF, D_MODEL), D_FF),
        'final_g': gain(ks[25], (D_MODEL,)),
    }


def reference(x, c, ctx, c_ctx, ada_w, ada_b, n1_g, ffn1_w1, ffn1_w3, ffn1_w2, n2_g, w_in, rpb,
              lam_q1, lam_k1, lam_q2, lam_k2, subln_g, w_pa, w_pb, w_o, n3_g,
              ffn2_w1, ffn2_w3, ffn2_w2, final_g):
    b, s, _ = x.shape
    cos, sin = rope_2d_tables(s)
    silu_c = jax.nn.silu(c)
    silu_cc = jax.nn.silu(c_ctx)
    xc = ctx
    for l in range(DEPTH):
        last = l == DEPTH - 1
        lam_init = 0.8 - 0.6 * math.exp(-0.3 * l)
        mod = (silu_c @ ada_w[l] + ada_b[l]).reshape(b, N_MOD, 1, D_MODEL)
        mod_c = (silu_cc @ ada_w[l] + ada_b[l]).reshape(N_MOD, 1, 1, D_MODEL)

        x = x + 0.5 * mod[:, 2] * swiglu(modulate(rmsnorm(x, n1_g[l]), mod[:, 0], mod[:, 1]),
                                         ffn1_w1[l], ffn1_w3[l], ffn1_w2[l])
        xc = xc + 0.5 * mod_c[2] * swiglu(modulate(rmsnorm(xc, n1_g[l]), mod_c[0], mod_c[1]),
                                          ffn1_w1[l], ffn1_w3[l], ffn1_w2[l])

        h = modulate(rmsnorm(x, n2_g[l]), mod[:, 3], mod[:, 4])
        hc = modulate(rmsnorm(xc, n2_g[l]), mod_c[3], mod_c[4])
        proj = h @ w_in[l]
        proj_c = hc @ (w_in[l][:, :KV_COLS] if last else w_in[l])
        k_a, v_a, k_b, v_b = split_kv(proj)
        k_ac, v_ac, k_bc, v_bc = split_kv(proj_c)
        q_a, q_b, g_a, g_b = split_q_gates(proj)
        q_b = apply_rope_2d(q_b, cos, sin)
        k_b = apply_rope_2d(k_b, cos, sin)
        lam = diff_lambda(lam_q1[l], lam_k1[l], lam_q2[l], lam_k2[l], lam_init)

        y_a = neighbourhood_attention(q_a, k_a, v_a, k_ac, v_ac, rpb[l])
        k_b_all = jnp.concatenate([k_b, k_bc], axis=1)
        v_b_all = jnp.concatenate([v_b, v_bc], axis=1)
        y_b = diff_post(diff_attention_latent(q_b, k_b_all, v_b_all, lam), subln_g[l], lam_init)
        x = x + mod[:, 5] * merge_branches(y_a, y_b, g_a, g_b, w_pa[l], w_pb[l], w_o[l])

        if not last:
            q_ac, q_bc, g_ac, g_bc = split_q_gates(proj_c)
            y_ac = ctx_attention(q_ac, k_ac, v_ac)
            y_bc = diff_post(diff_attend(q_bc, k_bc, v_bc, lam), subln_g[l], lam_init)
            xc = xc + mod_c[5] * merge_branches(y_ac, y_bc, g_ac, g_bc, w_pa[l], w_pb[l], w_o[l])

        x = x + 0.5 * mod[:, 8] * swiglu(modulate(rmsnorm(x, n3_g[l]), mod[:, 6], mod[:, 7]),
                                         ffn2_w1[l], ffn2_w3[l], ffn2_w2[l])
        if not last:
            xc = xc + 0.5 * mod_c[8] * swiglu(modulate(rmsnorm(xc, n3_g[l]), mod_c[6], mod_c[7]),
                                              ffn2_w1[l], ffn2_w3[l], ffn2_w2[l])
    return rmsnorm(x, final_g)
```

```cpp
#include <hip/hip_runtime.h>
#include <cstdio>
#include <cstdint>
namespace pg8 {
#define PG8_LAS __attribute__((address_space(3)))
#define PG8_GAS __attribute__((address_space(1)))
typedef unsigned short bf16_t;
typedef short bf16x8 __attribute__((ext_vector_type(8)));
typedef float f32x4 __attribute__((ext_vector_type(4)));
typedef unsigned u32x4 __attribute__((ext_vector_type(4)));
constexpr int BM = 256, BK = 64, HALF = 128, HTB = HALF * BK * 2  , STAGE_BYTES = 8 * HTB, NXCD = 8;
#ifndef PG8_WGM
#define PG8_WGM 4
#endif
constexpr int WGM = PG8_WGM;

__host__ __device__ __forceinline__ int lds_byte(int r, int c) { const int st = (r >> 4) * 2 + (c >> 5), rr = r & 15, cc = c & 31, ob = rr * 64 + cc * 2; return st * 1024 + (ob ^ (((ob >> 9) & 1) << 5)); }
__host__ __device__ __forceinline__ void stage_rc(int b, int& R, int& C) { const int st = b / 1024, sb = b % 1024, swz = sb ^ (((sb >> 9) & 1) << 5); R = (st >> 1) * 16 + swz / 64; C = (st & 1) * 32 + (swz % 64) / 2; }
__host__ __device__ __forceinline__ int perm32(int rho) { const int n = rho >> 4, i = rho & 15; return 8 * (i >> 2) + 4 * n + (i & 3); }

struct Unit { int pm, pn, koff, flags, nt; };
struct Gemm { const PG8_GAS bf16_t* A; const PG8_GAS bf16_t* Bt; int ld; };

struct GridOrder {
    int nM, nN, nwg, pm0, nM2, nN2, nwg2, pm02, G, c, passes, kpass, nt1, ks2, nt2, wgm, rot = 0, nrc = 0;
    __device__ __forceinline__ void init(int nM_, int nN_, int pm0_, int nM2_, int nN2_, int pm02_, int G_, int c_, int passes_, int kpass_, int nt1_, int ks2_ = 1, int nt2_ = 0) {
        nM = nM_; nN = nN_; nwg = nM_ * nN_; pm0 = pm0_; nM2 = nM2_; nN2 = nN2_; nwg2 = nM2_ * nN2_ * ks2_; pm02 = pm02_; G = G_; c = c_; passes = passes_; kpass = kpass_; nt1 = nt1_; ks2 = ks2_; nt2 = ks2_ == 1 ? nt1_ : nt2_; wgm = WGM; }
    __device__ __forceinline__ void decode(int wgid, int nM_, int nN_, int nwg_, int& pm, int& pn) const {
        { const int q = nwg_ / NXCD, r = nwg_ % NXCD, xcd = wgid % NXCD, off = wgid / NXCD; wgid = (xcd < r ? xcd * (q + 1) : r * (q + 1) + (xcd - r) * q) + off; }
        const int nig = wgm * nN_, gid = wgid / nig, fm = gid * wgm, gsz = (nM_ - fm) < wgm ? (nM_ - fm) : wgm;
        pm = fm + ((wgid % nig) % gsz); pn = (wgid % nig) / gsz; }
    __device__ __forceinline__ void set_rot(bool on) { const int total = nwg + nwg2; nrc = c < total ? (total - c + G - 1) / G : 0; rot = (on && nrc > 1) ? 1 : 0; }
    __device__ __forceinline__ bool idle_last() const { const int total = nwg + nwg2; if (total % G == 0) return false; return (long)(total / G) * G + c >= total; }
    __device__ __forceinline__ bool next(int i, Unit& u) const {
        int ti = passes == 2 ? (i >> 1) : i; const int ps = passes == 2 ? (i & 1) : 0;
        if (rot) { if (ti >= nrc) return false; ti += nrc - 1; if (ti >= nrc) ti -= nrc; }
        const long L = (long)ti * G + c;
        if (L < nwg) { decode((int)L, nM, nN, nwg, u.pm, u.pn); u.pm += pm0; u.koff = ps * kpass; u.flags = (ps == 0 ? 1 : 0) | (ps == passes - 1 ? 2 : 0); u.nt = nt1; }
        else if (L - nwg < nwg2) { const int L2 = (int)(L - nwg), q = L2 % ks2; decode(L2 / ks2, nM2, nN2, nwg2 / ks2, u.pm, u.pn); u.pm += pm02;
            if (ks2 == 1) { u.koff = ps * kpass; u.flags = (ps == 0 ? 1 : 0) | (ps == passes - 1 ? 2 : 0); } else { u.koff = q * nt2 * BK; u.flags = 3 | 4 | (q << 4); }
            u.nt = nt2; }
        else return false;
        return true; }
};

__device__ __forceinline__ unsigned cvt_pk_bf16(float lo, float hi) { unsigned r; asm volatile("v_cvt_pk_bf16_f32 %0, %1, %2" : "=v"(r) : "v"(lo), "v"(hi)); return r; }

template <class Epi, class Sched>
__device__ __forceinline__ void gemm_phase(PG8_LAS unsigned char* lds, const Gemm g, const Sched& S, const Epi& E) {
    int tid_ = threadIdx.x; asm volatile("" : "+v"(tid_));
    const int tid = tid_, wid = __builtin_amdgcn_readfirstlane(tid >> 6), lane = tid & 63, wr = wid >> 2, wc = wid & 3, fr = lane & 15, fq = lane >> 4;
    const int ld = g.ld;
    unsigned voffA[2], voffB[2];
#pragma unroll
    for (int i = 0; i < 2; ++i) { int R, C; stage_rc(tid * 16 + i * 8192, R, C); const int Rb = Epi::PERM ? ((R & ~31) + perm32(R & 31)) : R;
        voffA[i] = (unsigned)(R * ld + C) * 2u; voffB[i] = (unsigned)(Rb * ld + C) * 2u; }
    const size_t kstep = (size_t)(BK * 2);
    const size_t hstep = (size_t)HALF * ld * 2;
    const size_t tstep = 2 * hstep;
    const unsigned ldsw = (unsigned)wid * 1024u;
    const int aoff = lds_byte(wr * 64 + fr, fq * 8), boff = lds_byte(wc * 32 + fr, fq * 8);
#define PG8_SA(b, h) (((b) * 2 + (h)) * HTB)
#define PG8_SB(b, h) ((4 + (b) * 2 + (h)) * HTB)
#ifndef PG8_SP2
#define PG8_SP2 1
#endif
#ifndef PG8_SERP
#define PG8_SERP 0
#endif
#ifndef PG8_AUX_A
#define PG8_AUX_A 0
#endif
#ifndef PG8_AUX_B
#define PG8_AUX_B 0
#endif
#define PG8_STAGE_X(bufoff, gbase, voff, aux) do { _Pragma("unroll") for (int _i = 0; _i < 2; ++_i) \
        __builtin_amdgcn_global_load_lds((const PG8_GAS unsigned*)((gbase) + (voff)[_i]), (PG8_LAS unsigned*)(lds + (bufoff) + ldsw + _i * 8192), 16, 0, aux); } while (0)
#define PG8_STAGE(bufoff, gbase, voff) do { if ((bufoff) >= 4 * HTB) PG8_STAGE_X(bufoff, gbase, voff, PG8_AUX_B); else PG8_STAGE_X(bufoff, gbase, voff, PG8_AUX_A); } while (0)
#define PG8_LDA(dst, b, h) do { _Pragma("unroll") for (int m = 0; m < 4; ++m) _Pragma("unroll") for (int k = 0; k < 2; ++k) dst[m][k] = *(const PG8_LAS bf16x8*)(lds + PG8_SA(b, h) + aoff + m * 2048 + k * 1024); } while (0)
#define PG8_LDB(dst, b, h) do { _Pragma("unroll") for (int n = 0; n < 2; ++n) _Pragma("unroll") for (int k = 0; k < 2; ++k) dst[n][k] = *(const PG8_LAS bf16x8*)(lds + PG8_SB(b, h) + boff + n * 2048 + k * 1024); } while (0)
#ifndef PG8_PRIO
#define PG8_PRIO 0
#endif
#define PG8_MMA(ai, bj, At, Bt) do { if (PG8_PRIO == 0) __builtin_amdgcn_s_setprio(1); _Pragma("unroll") for (int m = 0; m < 4; ++m) _Pragma("unroll") for (int n = 0; n < 2; ++n) _Pragma("unroll") for (int k = 0; k < 2; ++k) \
        acc[ai][bj][m][n] = __builtin_amdgcn_mfma_f32_16x16x32_bf16(Bt[n][k], At[m][k], acc[ai][bj][m][n], 0, 0, 0); if (PG8_PRIO == 0) __builtin_amdgcn_s_setprio(0); } while (0)
#define PG8_WAIT_V(n) asm volatile("s_waitcnt vmcnt(" #n ")" ::: "memory")
#define PG8_WAIT_L(n) asm volatile("s_waitcnt lgkmcnt(" #n ")" ::: "memory")
#define PG8_BAR __builtin_amdgcn_s_barrier()
#define PG8_SCHED __builtin_amdgcn_sched_barrier(0)
    Unit cur, nxt; int ui = 0;
    if (!S.next(0, cur)) return;
    if (PG8_PRIO == 1 && wr == 1) __builtin_amdgcn_s_setprio(1);
    f32x4 acc[2][2][4][2];
#pragma unroll
    for (int a = 0; a < 2; ++a)
#pragma unroll
        for (int b = 0; b < 2; ++b)
#pragma unroll
            for (int m = 0; m < 4; ++m)
#pragma unroll
                for (int n = 0; n < 2; ++n) acc[a][b][m][n] = (f32x4){0.f, 0.f, 0.f, 0.f};
    bf16x8 At[4][2], B0[2][2], B1[2][2];
    long kd = (long)kstep;
    const PG8_GAS char* cA = (const PG8_GAS char*)g.A + (size_t)cur.pm * tstep + (size_t)cur.koff * 2; const PG8_GAS char* cB = (const PG8_GAS char*)g.Bt + (size_t)cur.pn * tstep + (size_t)cur.koff * 2;
#if PG8_SP2
    PG8_STAGE(PG8_SB(0, 0), cB, voffB); PG8_STAGE(PG8_SB(0, 1), cB + hstep, voffB); PG8_STAGE(PG8_SA(0, 0), cA, voffA); PG8_STAGE(PG8_SA(0, 1), cA + hstep, voffA);
    if (wr == 1) PG8_BAR;
    PG8_WAIT_V(2); PG8_BAR;
    PG8_STAGE(PG8_SB(1, 0), cB + kd, voffB); PG8_STAGE(PG8_SA(1, 0), cA + kd, voffA); PG8_STAGE(PG8_SB(1, 1), cB + hstep + kd, voffB);
    PG8_WAIT_V(6); PG8_BAR;
#else
    PG8_STAGE(PG8_SB(0, 0), cB, voffB); PG8_STAGE(PG8_SA(0, 0), cA, voffA); PG8_STAGE(PG8_SB(0, 1), cB + hstep, voffB); PG8_STAGE(PG8_SA(0, 1), cA + hstep, voffA);
    if (wr == 1) PG8_BAR;
    PG8_WAIT_V(4); PG8_BAR;
    PG8_STAGE(PG8_SB(1, 0), cB + kd, voffB); PG8_STAGE(PG8_SA(1, 0), cA + kd, voffA); PG8_STAGE(PG8_SB(1, 1), cB + hstep + kd, voffB);
    PG8_WAIT_V(6); PG8_BAR;
#endif
    for (;;) {
        const bool has_next = S.next(ui + 1, nxt);
        const bool nrev = PG8_SERP && has_next && ((ui + 1) & 1);
        const long nkd = has_next ? (nrev ? -(long)kstep : (long)kstep) : kd; const size_t nst = nrev ? (size_t)(nxt.nt - 1) * kstep : 0;
        const PG8_GAS char* nA = has_next ? (const PG8_GAS char*)g.A + (size_t)nxt.pm * tstep + (size_t)nxt.koff * 2 + nst : cA; const PG8_GAS char* nB = has_next ? (const PG8_GAS char*)g.Bt + (size_t)nxt.pn * tstep + (size_t)nxt.koff * 2 + nst : cB;
        const int nt = cur.nt;
        for (int t = 0; t < nt; t += 2) {
            const bool last = (t == nt - 2);
            const PG8_GAS char* a1 = cA + (long)(t + 1) * kd;
            const PG8_GAS char* a2 = last ? nA : cA + (long)(t + 2) * kd; const PG8_GAS char* b2 = last ? nB : cB + (long)(t + 2) * kd;
            const long kd3 = last ? nkd : kd; const PG8_GAS char* a3 = a2 + kd3; const PG8_GAS char* b3 = b2 + kd3;
#if PG8_SP2
            PG8_LDB(B0, 0, 0); PG8_LDB(B1, 0, 1); PG8_SCHED; PG8_LDA(At, 0, 0); PG8_STAGE(PG8_SA(1, 1), a1 + hstep, voffA);
            PG8_WAIT_V(8); PG8_WAIT_L(0); PG8_BAR; PG8_MMA(0, 0, At, B0); PG8_MMA(0, 1, At, B1); PG8_BAR; PG8_SCHED;
            PG8_LDA(At, 0, 1); PG8_STAGE(PG8_SB(0, 0), b2, voffB); PG8_STAGE(PG8_SB(0, 1), b2 + hstep, voffB); PG8_STAGE(PG8_SA(0, 0), a2, voffA);
            PG8_WAIT_V(8); PG8_WAIT_L(0); PG8_BAR; PG8_MMA(1, 0, At, B0); PG8_MMA(1, 1, At, B1); PG8_BAR; PG8_SCHED;
            PG8_LDB(B0, 1, 0); PG8_LDB(B1, 1, 1); PG8_SCHED; PG8_LDA(At, 1, 0); PG8_STAGE(PG8_SA(0, 1), a2 + hstep, voffA);
            PG8_WAIT_V(8); PG8_WAIT_L(0); PG8_BAR; PG8_MMA(0, 0, At, B0); PG8_MMA(0, 1, At, B1); PG8_BAR; PG8_SCHED;
            PG8_LDA(At, 1, 1); PG8_STAGE(PG8_SB(1, 0), b3, voffB); PG8_STAGE(PG8_SB(1, 1), b3 + hstep, voffB); PG8_STAGE(PG8_SA(1, 0), a3, voffA);
            PG8_WAIT_V(8); PG8_WAIT_L(0); PG8_BAR; PG8_MMA(1, 0, At, B0); PG8_MMA(1, 1, At, B1); PG8_BAR; PG8_SCHED;
#else
            PG8_LDB(B0, 0, 0); PG8_SCHED; PG8_LDA(At, 0, 0); PG8_STAGE(PG8_SA(1, 1), a1 + hstep, voffA);
            PG8_WAIT_L(8); PG8_BAR; PG8_WAIT_L(0); PG8_MMA(0, 0, At, B0); PG8_BAR; PG8_SCHED;
            PG8_LDB(B1, 0, 1); PG8_STAGE(PG8_SB(0, 0), b2, voffB);
            PG8_BAR; PG8_WAIT_L(0); PG8_MMA(0, 1, At, B1); PG8_BAR;
            PG8_LDA(At, 0, 1); PG8_STAGE(PG8_SA(0, 0), a2, voffA);
            PG8_BAR; PG8_WAIT_L(0); PG8_MMA(1, 0, At, B0); PG8_BAR; PG8_SCHED;
            PG8_STAGE(PG8_SB(0, 1), b2 + hstep, voffB);
            PG8_WAIT_V(6); PG8_BAR; PG8_MMA(1, 1, At, B1); PG8_BAR;
            PG8_LDB(B0, 1, 0); PG8_SCHED; PG8_LDA(At, 1, 0); PG8_STAGE(PG8_SA(0, 1), a2 + hstep, voffA);
            PG8_WAIT_L(8); PG8_BAR; PG8_WAIT_L(0); PG8_MMA(0, 0, At, B0); PG8_BAR; PG8_SCHED;
            PG8_LDB(B1, 1, 1); PG8_STAGE(PG8_SB(1, 0), b3, voffB);
            PG8_BAR; PG8_WAIT_L(0); PG8_MMA(0, 1, At, B1); PG8_BAR;
            PG8_LDA(At, 1, 1); PG8_STAGE(PG8_SA(1, 0), a3, voffA);
            PG8_BAR; PG8_WAIT_L(0); PG8_MMA(1, 0, At, B0); PG8_BAR; PG8_SCHED;
            PG8_STAGE(PG8_SB(1, 1), b3 + hstep, voffB);
            PG8_WAIT_V(6); PG8_BAR; PG8_MMA(1, 1, At, B1); PG8_BAR;
#endif
        }
        if (wr == 0) PG8_BAR;
        E(acc, cur, wr, wc, fr, fq);
        if (!has_next) break;
        if (nxt.flags & 1) {
#pragma unroll
        for (int a = 0; a < 2; ++a)
#pragma unroll
            for (int b = 0; b < 2; ++b)
#pragma unroll
                for (int m = 0; m < 4; ++m)
#pragma unroll
                    for (int n = 0; n < 2; ++n) acc[a][b][m][n] = (f32x4){0.f, 0.f, 0.f, 0.f};
        }
        cur = nxt; cA = nA; cB = nB; kd = nkd; ++ui;
        if (wr == 1) PG8_BAR;
    }
    if (PG8_PRIO == 1) __builtin_amdgcn_s_setprio(0);
    PG8_WAIT_V(0);
    PG8_BAR;
#undef PG8_SA
#undef PG8_SB
#undef PG8_STAGE
#undef PG8_STAGE_X
#undef PG8_LDA
#undef PG8_LDB
#undef PG8_MMA
#undef PG8_WAIT_V
#undef PG8_WAIT_L
#undef PG8_BAR
#undef PG8_SCHED
}
}
namespace pg8 {
typedef PG8_GAS bf16_t gbf; typedef PG8_GAS float gfl; typedef PG8_GAS f32x4 gf4; typedef PG8_GAS u32x4 gu4;
#ifndef WT_STORES
#define WT_STORES 0
#endif
#ifndef NT_EPI
#define NT_EPI 0
#endif
__device__ __forceinline__ void st16(gu4* p, u32x4 v) {
#if WT_STORES
    asm volatile("global_store_dwordx4 %0, %1, off sc1" :: "v"(p), "v"(v) : "memory");
#elif NT_EPI
    __builtin_nontemporal_store(v, p);
#else
    *p = v;
#endif
}
__device__ __forceinline__ void st16f(gf4* p, f32x4 v) {
#if WT_STORES
    asm volatile("global_store_dwordx4 %0, %1, off sc1" :: "v"(p), "v"(v) : "memory");
#elif NT_EPI
    __builtin_nontemporal_store(v, p);
#else
    *p = v;
#endif
}
#ifndef RESID_BATCH
#define RESID_BATCH 4
#endif
#ifndef NT_P
#define NT_P 0
#endif
__device__ __forceinline__ void st16p(gu4* p, u32x4 v) {
#if NT_P
    __builtin_nontemporal_store(v, p);
#else
    *p = v;
#endif
}
__device__ __forceinline__ f32x4 ld16f(const gf4* p) {
#if NT_EPI
    return __builtin_nontemporal_load(p);
#else
    return *p;
#endif
}
__device__ __forceinline__ float fast_sigmoid(float x) { return __builtin_amdgcn_rcpf(1.0f + __builtin_amdgcn_exp2f(-1.4426950408889634f * x)); }
__device__ __forceinline__ float bf_lo(unsigned w) { return __uint_as_float(w << 16); }
__device__ __forceinline__ float bf_hi(unsigned w) { return __uint_as_float(w & 0xffff0000u); }

struct EpiBf16 {
    static constexpr bool PERM = true; static constexpr int IDEMP = 1;
    gbf* O; int ldc;
    __device__ __forceinline__ void operator()(f32x4 (&acc)[2][2][4][2], const Unit& u, int wr, int wc, int fr, int fq) const {
        const int row0 = u.pm * BM + wr * 64 + fr, col0 = u.pn * BM + wc * 32 + 8 * fq;
#pragma unroll
        for (int ai = 0; ai < 2; ++ai)
#pragma unroll
            for (int m = 0; m < 4; ++m) { gbf* rowp = O + (size_t)(row0 + ai * HALF + m * 16) * ldc + col0;
#pragma unroll
                for (int bj = 0; bj < 2; ++bj) { const f32x4 v0 = acc[ai][bj][m][0], v1 = acc[ai][bj][m][1];
                    u32x4 w; w.x = cvt_pk_bf16(v0[0], v0[1]); w.y = cvt_pk_bf16(v0[2], v0[3]); w.z = cvt_pk_bf16(v1[0], v1[1]); w.w = cvt_pk_bf16(v1[2], v1[3]);
                    st16((gu4*)(rowp + bj * HALF), w); } }
    }
};

struct EpiInproj {
    static constexpr bool PERM = true; static constexpr int IDEMP = 1;
    gbf* O; int ldc; const gfl* ropeC; const gfl* ropeS; int MLr;
    __device__ __forceinline__ void operator()(f32x4 (&acc)[2][2][4][2], const Unit& u, int wr, int wc, int fr, int fq) const {
        const int row0 = u.pm * BM + wr * 64 + fr, col0 = u.pn * BM + wc * 32 + 8 * fq;
        const bool rot = ((u.pn >= 8 && u.pn < 12) || (u.pn >= 20 && u.pn < 24)) && (u.pm * BM) < MLr;
        const int toff = (wc >> 1) * 32 + 16 * (wc & 1) + 4 * fq;
        if (rot) {
#pragma unroll
            for (int ai = 0; ai < 2; ++ai) {
                f32x4 cs[4], sn[4];
#pragma unroll
                for (int m = 0; m < 4; ++m) { const int t = (row0 + ai * HALF + m * 16) & 2047; cs[m] = *(const gf4*)(ropeC + t * 64 + toff); sn[m] = *(const gf4*)(ropeS + t * 64 + toff); }
#pragma unroll
                for (int m = 0; m < 4; ++m) { gbf* rowp = O + (size_t)(row0 + ai * HALF + m * 16) * ldc + col0;
#pragma unroll
                    for (int bj = 0; bj < 2; ++bj) { const f32x4 x0 = acc[ai][bj][m][0], x1 = acc[ai][bj][m][1];
                        const f32x4 v0 = x0 * cs[m] - x1 * sn[m], v1 = x0 * sn[m] + x1 * cs[m];
                        u32x4 w; w.x = cvt_pk_bf16(v0[0], v0[1]); w.y = cvt_pk_bf16(v0[2], v0[3]); w.z = cvt_pk_bf16(v1[0], v1[1]); w.w = cvt_pk_bf16(v1[2], v1[3]);
                        st16p((gu4*)(rowp + bj * HALF), w); } } }
        } else {
#pragma unroll
            for (int ai = 0; ai < 2; ++ai)
#pragma unroll
                for (int m = 0; m < 4; ++m) { gbf* rowp = O + (size_t)(row0 + ai * HALF + m * 16) * ldc + col0;
#pragma unroll
                    for (int bj = 0; bj < 2; ++bj) { const f32x4 v0 = acc[ai][bj][m][0], v1 = acc[ai][bj][m][1];
                        u32x4 w; w.x = cvt_pk_bf16(v0[0], v0[1]); w.y = cvt_pk_bf16(v0[2], v0[3]); w.z = cvt_pk_bf16(v1[0], v1[1]); w.w = cvt_pk_bf16(v1[2], v1[3]);
                        st16p((gu4*)(rowp + bj * HALF), w); } }
        }
    }
};

struct EpiSwiglu {
    static constexpr bool PERM = false; static constexpr int IDEMP = 2;
    gbf* U; int ldc;
    __device__ __forceinline__ void operator()(f32x4 (&acc)[2][2][4][2], const Unit& u, int wr, int wc, int fr, int fq) const {
        const int row0 = u.pm * BM + wr * 64 + fr, col0 = u.pn * HALF + wc * 32 + 8 * fq;
#pragma unroll
        for (int ai = 0; ai < 2; ++ai)
#pragma unroll
            for (int m = 0; m < 4; ++m) { gbf* rowp = U + (size_t)(row0 + ai * HALF + m * 16) * ldc + col0;
                f32x4 h[2];
#pragma unroll
                for (int bj = 0; bj < 2; ++bj) { const f32x4 gt = acc[ai][bj][m][0], up = acc[ai][bj][m][1];
#pragma unroll
                    for (int e = 0; e < 4; ++e) h[bj][e] = gt[e] * fast_sigmoid(gt[e]) * up[e]; }
                u32x4 w; w.x = cvt_pk_bf16(h[0][0], h[0][1]); w.y = cvt_pk_bf16(h[0][2], h[0][3]); w.z = cvt_pk_bf16(h[1][0], h[1][1]); w.w = cvt_pk_bf16(h[1][2], h[1][3]);
                st16((gu4*)rowp, w); }
    }
};

struct EpiResid {
    static constexpr bool PERM = false; static constexpr int IDEMP = 0;
    const gfl* baseL; const gfl* baseC; gfl* out; const gfl* modl; int gate_off; float gs; int MLr; gfl* slab;
    __device__ __forceinline__ void operator()(f32x4 (&acc)[2][2][4][2], const Unit& u, int wr, int wc, int fr, int fq) const {
        const int row0 = u.pm * BM + wr * 64 + fr, col0 = u.pn * BM + wc * 32 + 4 * fq;
        if (u.flags & 4) {
            gbf* sp = (gbf*)slab + ((size_t)((u.flags >> 4) & 3) * 2048 + (size_t)(row0 - MLr)) * 2048 + col0;
#pragma unroll
            for (int ai = 0; ai < 2; ++ai)
#pragma unroll
                for (int m = 0; m < 4; ++m) { const size_t ro = (size_t)(ai * HALF + m * 16) * 2048;
#pragma unroll
                    for (int bj = 0; bj < 2; ++bj)
#pragma unroll
                        for (int n = 0; n < 2; ++n) { const f32x4 v = acc[ai][bj][m][n]; typedef unsigned u32x2 __attribute__((ext_vector_type(2)));
                            u32x2 w; w.x = cvt_pk_bf16(v[0], v[1]); w.y = cvt_pk_bf16(v[2], v[3]); *(PG8_GAS u32x2*)(sp + ro + bj * HALF + n * 16) = w; } }
            return; }
        const bool isL = (u.pm * BM) < MLr;
        const int r = isL ? (u.pm * BM) >> 11 : 8;
        const gfl* gp = modl + (size_t)r * 18432 + gate_off + col0;
        const gfl* bp = isL ? baseL + (size_t)row0 * 2048 + col0 : baseC + (size_t)(row0 - MLr) * 2048 + col0;
        gfl* op = out + (size_t)row0 * 2048 + col0;
        f32x4 gv[2][2];
#pragma unroll
        for (int bj = 0; bj < 2; ++bj)
#pragma unroll
            for (int n = 0; n < 2; ++n) gv[bj][n] = *(const gf4*)(gp + bj * HALF + n * 16) * gs;
#pragma unroll
        for (int ai = 0; ai < 2; ++ai)
#pragma unroll
            for (int mh = 0; mh < 4; mh += RESID_BATCH) {
                f32x4 bs[RESID_BATCH][2][2];
#pragma unroll
                for (int m = 0; m < RESID_BATCH; ++m) { const size_t ro = (size_t)(ai * HALF + (mh + m) * 16) * 2048;
#pragma unroll
                    for (int bj = 0; bj < 2; ++bj)
#pragma unroll
                        for (int n = 0; n < 2; ++n) bs[m][bj][n] = ld16f((const gf4*)(bp + ro + bj * HALF + n * 16)); }
#pragma unroll
                for (int m = 0; m < RESID_BATCH; ++m) { const size_t ro = (size_t)(ai * HALF + (mh + m) * 16) * 2048;
#pragma unroll
                    for (int bj = 0; bj < 2; ++bj)
#pragma unroll
                        for (int n = 0; n < 2; ++n) st16f((gf4*)(op + ro + bj * HALF + n * 16), bs[m][bj][n] + gv[bj][n] * acc[ai][bj][mh + m][n]); }
                asm volatile("" ::: "memory"); }
    }
};

struct EpiMerge1 {
    static constexpr bool PERM = true; static constexpr int IDEMP = 0;
    const gbf* Pg; int ldp; gbf* Z; int ldz;
    __device__ __forceinline__ void operator()(f32x4 (&acc)[2][2][4][2], const Unit& u, int wr, int wc, int fr, int fq) const {
        const int row0 = u.pm * BM + wr * 64 + fr, col0 = u.pn * BM + wc * 32 + 8 * fq;
        const bool fin = (u.flags & 2) != 0;
#pragma unroll
        for (int ai = 0; ai < 2; ++ai) {
            u32x4 pbv[4][2], pav[4][2];
#pragma unroll
            for (int m = 0; m < 4; ++m)
#pragma unroll
                for (int bj = 0; bj < 2; ++bj) { const gbf* gp = Pg + (size_t)(row0 + ai * HALF + m * 16) * ldp + col0 + bj * HALF;
                    pbv[m][bj] = *(const gu4*)(gp + 2048); if (!fin) pav[m][bj] = *(const gu4*)gp; }
#pragma unroll
            for (int m = 0; m < 4; ++m) { const size_t rrow = (size_t)(row0 + ai * HALF + m * 16);
#pragma unroll
                for (int bj = 0; bj < 2; ++bj) { const u32x4 pb = pbv[m][bj];
                    float gb[8]; gb[0] = bf_lo(pb.x); gb[1] = bf_hi(pb.x); gb[2] = bf_lo(pb.y); gb[3] = bf_hi(pb.y); gb[4] = bf_lo(pb.z); gb[5] = bf_hi(pb.z); gb[6] = bf_lo(pb.w); gb[7] = bf_hi(pb.w);
                    if (!fin) {
                        const u32x4 pa = pav[m][bj];
                        float ga[8]; ga[0] = bf_lo(pa.x); ga[1] = bf_hi(pa.x); ga[2] = bf_lo(pa.y); ga[3] = bf_hi(pa.y); ga[4] = bf_lo(pa.z); ga[5] = bf_hi(pa.z); ga[6] = bf_lo(pa.w); ga[7] = bf_hi(pa.w);
#pragma unroll
                        for (int e = 0; e < 8; ++e) {
                            const float ra = (1.0f + __builtin_amdgcn_exp2f(-1.4426950408889634f * gb[e])) * __builtin_amdgcn_rcpf(1.0f + __builtin_amdgcn_exp2f(-1.4426950408889634f * ga[e]));
                            acc[ai][bj][m][e >> 2][e & 3] *= ra; }
                    } else {
                        float z[8];
#pragma unroll
                        for (int e = 0; e < 8; ++e) z[e] = acc[ai][bj][m][e >> 2][e & 3] * fast_sigmoid(gb[e]);
                        u32x4 w; w.x = cvt_pk_bf16(z[0], z[1]); w.y = cvt_pk_bf16(z[2], z[3]); w.z = cvt_pk_bf16(z[4], z[5]); w.w = cvt_pk_bf16(z[6], z[7]);
                        st16((gu4*)(Z + rrow * ldz + col0 + bj * HALF), w); } } }
        }
    }
};
}
namespace att {
typedef unsigned short bf16_t;
using bf16x8 = __attribute__((ext_vector_type(8))) short;
using s16x4  = __attribute__((ext_vector_type(4))) short;
using f32x16 = __attribute__((ext_vector_type(16))) float;
using u32x4  = __attribute__((ext_vector_type(4))) unsigned;
#define ATT_LAS __attribute__((address_space(3)))
#define ATT_GAS __attribute__((address_space(1)))
typedef ATT_GAS unsigned short gbf; typedef ATT_GAS bf16x8 gbf8;
constexpr int   D = 128, NW = 8, QBLK = 32, KVBLK = 64, LDP = 10240;
constexpr float SCALE = 0.088388347648318440f;
constexpr float THR = 8.f;
constexpr int SHM_V = KVBLK * D * 2, SHM_K = KVBLK * D * 2, SHM_ATTN = 2 * SHM_V + 2 * SHM_K + NW * 64 * 4;
constexpr int TBL_OFF = SHM_ATTN, TBL_BYTES = 15 * 128 * 4;
constexpr int ST_OFF = TBL_OFF + TBL_BYTES, ST_PITCH = 272, ST_WAVE = 32 * ST_PITCH, ATT_LDS_BYTES = ST_OFF + NW * ST_WAVE;
#define KSWZ(row, colB) ((row) * 256 + ((colB) ^ (((row) & 7) << 4)))
#define SBAR() __builtin_amdgcn_sched_barrier(0)
__device__ __forceinline__ int crow(int r, int hi) { return (r & 3) + 8 * (r >> 2) + 4 * hi; }
__device__ __forceinline__ unsigned cvtpk(float lo, float hi) { unsigned r; asm volatile("v_cvt_pk_bf16_f32 %0, %1, %2" : "=v"(r) : "v"(lo), "v"(hi)); return r; }

#ifndef ATT_NOMAX
#define ATT_NOMAX 0
#endif
__device__ __forceinline__ void partialSM(f32x16& p0, f32x16& p1, float& m_reg, float& mn, float& alpha) {
  constexpr float C = SCALE * 1.4426950408889634f;
#if ATT_NOMAX
  mn = 0.f; alpha = 1.f;
#pragma unroll
  for (int r = 0; r < 16; ++r) p0[r] = __builtin_amdgcn_exp2f(fminf(p0[r] * C, 100.f));
#pragma unroll
  for (int r = 0; r < 16; ++r) p1[r] = fminf(p1[r] * C, 100.f);
  return;
#endif
  float pmax = p0[0];
#pragma unroll
  for (int r = 1; r < 16; ++r) pmax = fmaxf(pmax, p0[r]);
#pragma unroll
  for (int r = 0; r < 16; ++r) pmax = fmaxf(pmax, p1[r]);
  { auto rr = __builtin_amdgcn_permlane32_swap(__float_as_uint(pmax), __float_as_uint(pmax), false, false);
    pmax = fmaxf(__uint_as_float(rr[0]), __uint_as_float(rr[1])); }
  if (__builtin_expect(__all(pmax - m_reg <= THR / SCALE), 1)) { mn = m_reg; alpha = 1.f; }
  else { mn = fmaxf(m_reg, pmax); alpha = __builtin_amdgcn_exp2f((m_reg - mn) * C); m_reg = mn; }
  float mnC = -mn * C;
#pragma unroll
  for (int r = 0; r < 16; ++r) p0[r] = fmaf(p0[r], C, mnC);
#pragma unroll
  for (int r = 0; r < 16; ++r) p1[r] = fmaf(p1[r], C, mnC);
#pragma unroll
  for (int r = 0; r < 16; ++r) p0[r] = __builtin_amdgcn_exp2f(p0[r]);
}
__device__ __forceinline__ void finishSM(f32x16& p0, f32x16& p1, float alpha, float& l_reg, bf16x8& pa0, bf16x8& pa1, bf16x8& pa2, bf16x8& pa3) {
#pragma unroll
  for (int r = 0; r < 16; ++r) p1[r] = __builtin_amdgcn_exp2f(p1[r]);
  float ps = 0;
#pragma unroll
  for (int r = 0; r < 16; ++r) ps += p0[r];
#pragma unroll
  for (int r = 0; r < 16; ++r) ps += p1[r];
  { auto rr = __builtin_amdgcn_permlane32_swap(__float_as_uint(ps), __float_as_uint(ps), false, false);
    ps = __uint_as_float(rr[0]) + __uint_as_float(rr[1]); }
  l_reg = l_reg * alpha + ps;
#define PK4(P, BASE, OUT) do { unsigned a0 = cvtpk(P[BASE + 0], P[BASE + 1]), a1 = cvtpk(P[BASE + 2], P[BASE + 3]);   \
    unsigned b0 = cvtpk(P[BASE + 4], P[BASE + 5]), b1 = cvtpk(P[BASE + 6], P[BASE + 7]);                              \
    auto r0 = __builtin_amdgcn_permlane32_swap(a0, b0, false, false); auto r1 = __builtin_amdgcn_permlane32_swap(a1, b1, false, false); \
    u32x4 w = {r0[0], r1[0], r0[1], r1[1]}; OUT = *reinterpret_cast<bf16x8*>(&w); } while (0)
  PK4(p0, 0, pa0); PK4(p0, 8, pa1); PK4(p1, 0, pa2); PK4(p1, 8, pa3);
#undef PK4
}
__device__ __forceinline__ void qkt(f32x16& p0, f32x16& p1, const char* Ks, const bf16x8* qr, int r32, int hi) {
#ifdef ATT_PROBE_QK2
  p0 = f32x16{}; p1 = f32x16{};
#pragma unroll
  for (int d0 = 0; d0 < 8; ++d0) { int cb = (d0 * 16 + hi * 8) * 2;
    bf16x8 b0 = *reinterpret_cast<const bf16x8*>(Ks + KSWZ(r32, cb));
    bf16x8 b1 = *reinterpret_cast<const bf16x8*>(Ks + KSWZ(32 + r32, cb));
    p0 = __builtin_amdgcn_mfma_f32_32x32x16_bf16(b0, qr[d0], p0, 0, 0, 0);
    p1 = __builtin_amdgcn_mfma_f32_32x32x16_bf16(b1, qr[d0], p1, 0, 0, 0); }
  asm volatile("" : "+v"(p0), "+v"(p1));
#endif
  p0 = f32x16{}; p1 = f32x16{};
#pragma unroll
  for (int d0 = 0; d0 < 8; ++d0) { int cb = (d0 * 16 + hi * 8) * 2;
    bf16x8 b0 = *reinterpret_cast<const bf16x8*>(Ks + KSWZ(r32, cb));
    bf16x8 b1 = *reinterpret_cast<const bf16x8*>(Ks + KSWZ(32 + r32, cb));
    p0 = __builtin_amdgcn_mfma_f32_32x32x16_bf16(b0, qr[d0], p0, 0, 0, 0);
    p1 = __builtin_amdgcn_mfma_f32_32x32x16_bf16(b1, qr[d0], p1, 0, 0, 0); }
}
__device__ __forceinline__ int v_st(int k, int c) { const int kk = (k & ~0xC) | ((k & 4) << 1) | ((k & 8) >> 1); return ((kk >> 3) * 4 + (c >> 5)) * 512 + ((kk & 7) * 32 + (c & 31)) * 2; }
__device__ __forceinline__ int v_rd_base(int lane) { return ((lane & 3) << 3) | (((lane >> 2) & 3) << 6) | (((lane >> 4) & 1) << 5) | (((lane >> 5) & 1) << 8); }
constexpr int v_rd_off(int d0, int ks, int half) { return d0 * 512 + ks * 4096 + half * 2048; }
template <int OFF> __device__ __forceinline__ s16x4 tr_read(int vb) {
  s16x4 r; asm volatile("ds_read_b64_tr_b16 %0, %1 offset:%2" : "=&v"(r) : "v"(vb), "i"(OFF) : "memory"); return r;
}
template <int D0> __device__ __forceinline__ void pv_one(f32x16& od, int vb, bf16x8 pa0, bf16x8 pa1, bf16x8 pa2, bf16x8 pa3) {
  const s16x4 l0 = tr_read<v_rd_off(D0, 0, 0)>(vb), h0 = tr_read<v_rd_off(D0, 0, 1)>(vb), l1 = tr_read<v_rd_off(D0, 1, 0)>(vb), h1 = tr_read<v_rd_off(D0, 1, 1)>(vb);
  const s16x4 l2 = tr_read<v_rd_off(D0, 2, 0)>(vb), h2 = tr_read<v_rd_off(D0, 2, 1)>(vb), l3 = tr_read<v_rd_off(D0, 3, 0)>(vb), h3 = tr_read<v_rd_off(D0, 3, 1)>(vb);
  asm volatile("s_waitcnt lgkmcnt(0)" ::: "memory"); SBAR();
#define PK(L, H) (bf16x8){L[0], L[1], L[2], L[3], H[0], H[1], H[2], H[3]}
  od = __builtin_amdgcn_mfma_f32_32x32x16_bf16(pa0, PK(l0, h0), od, 0, 0, 0);
  od = __builtin_amdgcn_mfma_f32_32x32x16_bf16(pa1, PK(l1, h1), od, 0, 0, 0);
  od = __builtin_amdgcn_mfma_f32_32x32x16_bf16(pa2, PK(l2, h2), od, 0, 0, 0);
  od = __builtin_amdgcn_mfma_f32_32x32x16_bf16(pa3, PK(l3, h3), od, 0, 0, 0);
#undef PK
}
__device__ __forceinline__ void pv_d0(f32x16* o, int vb, bf16x8 pa0, bf16x8 pa1, bf16x8 pa2, bf16x8 pa3) {
  pv_one<0>(o[0], vb, pa0, pa1, pa2, pa3); pv_one<1>(o[1], vb, pa0, pa1, pa2, pa3); pv_one<2>(o[2], vb, pa0, pa1, pa2, pa3); pv_one<3>(o[3], vb, pa0, pa1, pa2, pa3);
}

struct Unit {
  const gbf* Q;
  const gbf* K0; const gbf* K1; int n0; int dv; int NT;
  gbf* O; int ldo;
  int r0, kr_lo, ntl;
};

template <bool NA>
__device__ __forceinline__ void na_bias(f32x16& p0, f32x16& p1, int j, const Unit& u, int rgrid, int rs, int cs, int hi, const float* lrow) {
  if constexpr (NA) {
    if (j >= u.n0) {
      const int jl = j - u.n0, kr = u.kr_lo + jl;
      if (jl < u.ntl && (unsigned)(kr - rs) < 8u) {
        const float* row = lrow + (kr - rgrid + 7) * 128;
#pragma unroll
        for (int g = 0; g < 4; ++g) {
          float b0[4], b1[4];
#pragma unroll
          for (int q = 0; q < 4; ++q) { const int cr = q + 8 * g; b0[q] = row[cr]; b1[q] = row[cr + 32]; }
#pragma unroll
          for (int q = 0; q < 4; ++q) { const int r = 4 * g + q, kc = q + 8 * g + 4 * hi;
            p0[r] = ((unsigned)(kc - cs) < 16u) ? p0[r] + b0[q] : -1e30f;
            p1[r] = ((unsigned)(kc + 32 - cs) < 16u) ? p1[r] + b1[q] : -1e30f; }
          asm volatile("" ::: "memory");
        }
      } else {
#pragma unroll
        for (int r = 0; r < 16; ++r) { p0[r] = -1e30f; p1[r] = -1e30f; }
      }
    }
  }
}

template <bool NA, int SD>
__device__ __forceinline__ void attn_unit(const Unit& u, char* lds) {
  int tid_ = threadIdx.x; asm volatile("" : "+v"(tid_));
  const int tid = tid_, wid = __builtin_amdgcn_readfirstlane(tid >> 6), lane = tid & 63, r32 = lane & 31, hi = lane >> 5;
  char* V_lds = lds; char* K_lds = lds + 2 * SHM_V;
  float* ws = (float*)(lds + 2 * SHM_V + 2 * SHM_K) + wid * 64; float* li_l = ws; float* al_l = ws + 32;
  float m_reg = -1e30f, l_reg = 0; f32x16 o[4] = {}; bf16x8 qr[8];
  const gbf* Qw = u.Q + (long)(wid * QBLK + r32) * LDP + hi * 8;
#pragma unroll
  for (int d0 = 0; d0 < 8; ++d0) qr[d0] = *(const gbf8*)(Qw + d0 * 16);
  const int sr = tid >> 4, sc = (tid & 15) * 8, vst0 = v_st(sr, sc), vst1 = v_st(32 + sr, sc);
  const int vb0 = (int)(uintptr_t)V_lds + v_rd_base(lane);
  const int rgrid = u.r0 + (wid >> 1), rs = rgrid - 4 < 0 ? 0 : (rgrid - 4 > 24 ? 24 : rgrid - 4);
  const int qc = (wid & 1) * 32 + r32, cs = qc - 8 < 0 ? 0 : (qc - 8 > 48 ? 48 : qc - 8);
  const float* lrow = (const float*)(lds + TBL_OFF) + (48 + 4 * hi - qc + 15);
  struct { bf16x8 vs0, vs1, ks0, ks1; } sr_[SD];
#define KTILE(j) ((j) < u.n0 ? u.K0 + (size_t)(j) * (KVBLK * LDP) : u.K1 + (size_t)((j) - u.n0) * (KVBLK * LDP))
#define SLOAD(i, j) do { const gbf* kt_ = KTILE(j) + (size_t)sr * LDP + sc; \
    sr_[i].vs0 = *(const gbf8*)(kt_ + u.dv); sr_[i].vs1 = *(const gbf8*)(kt_ + u.dv + 32 * LDP); \
    sr_[i].ks0 = *(const gbf8*)(kt_); sr_[i].ks1 = *(const gbf8*)(kt_ + 32 * LDP); } while (0)
#define SWRITE(b, i) do { *(bf16x8*)(V_lds + (b) * SHM_V + vst0) = sr_[i].vs0;          \
    *(bf16x8*)(V_lds + (b) * SHM_V + vst1) = sr_[i].vs1; int kc_ = sc * 2;               \
    *(bf16x8*)(K_lds + (b) * SHM_K + KSWZ(sr, kc_)) = sr_[i].ks0;                       \
    *(bf16x8*)(K_lds + (b) * SHM_K + KSWZ(32 + sr, kc_)) = sr_[i].ks1; } while (0)
#define SWAIT() do { if constexpr (SD == 2) asm volatile("s_waitcnt vmcnt(4)" ::: "memory"); else asm volatile("s_waitcnt vmcnt(0)" ::: "memory"); } while (0)
#define RESC(a) do { if (__any((a) < 1.f)) { if (hi == 0) al_l[r32] = (a); asm volatile("s_waitcnt lgkmcnt(0)" ::: "memory"); \
    _Pragma("unroll") for (int d = 0; d < 4; ++d) _Pragma("unroll") for (int r = 0; r < 16; ++r) o[d][r] *= al_l[crow(r, hi)]; } } while (0)
  f32x16 pA0, pA1, pB0, pB1; float mnA, mnB, alA, alB; bf16x8 pa0, pa1, pa2, pa3; const int NT = u.NT;
  constexpr int SE = 0, SO = SD - 1;
  SLOAD(SE, 0); asm volatile("s_waitcnt vmcnt(0)" ::: "memory"); SWRITE(0, SE); __syncthreads();
  qkt(pA0, pA1, K_lds, qr, r32, hi); na_bias<NA>(pA0, pA1, 0, u, rgrid, rs, cs, hi, lrow); partialSM(pA0, pA1, m_reg, mnA, alA);
  SLOAD(SO, 1); if constexpr (SD == 2) { if (2 < NT) SLOAD(SE, 2); }
  SWAIT(); SWRITE(1, SO); __syncthreads();
  for (int j = 1; j + 1 < NT; j += 2) {
    SBAR(); qkt(pB0, pB1, K_lds + SHM_K, qr, r32, hi);
    finishSM(pA0, pA1, alA, l_reg, pa0, pa1, pa2, pa3); SBAR();
    SLOAD(SO, j + SD); SBAR();
    pv_d0(o, vb0, pa0, pa1, pa2, pa3); na_bias<NA>(pB0, pB1, j, u, rgrid, rs, cs, hi, lrow); partialSM(pB0, pB1, m_reg, mnB, alB);
    __syncthreads(); SWAIT(); SWRITE(0, SE);
    RESC(alB); __syncthreads();
    SBAR(); qkt(pA0, pA1, K_lds, qr, r32, hi);
    finishSM(pB0, pB1, alB, l_reg, pa0, pa1, pa2, pa3); SBAR();
    if (SD == 1 || j + 3 < NT) SLOAD(SE, j + 1 + SD); SBAR();
    pv_d0(o, vb0 + SHM_V, pa0, pa1, pa2, pa3); na_bias<NA>(pA0, pA1, j + 1, u, rgrid, rs, cs, hi, lrow); partialSM(pA0, pA1, m_reg, mnA, alA);
    __syncthreads(); SWAIT(); SWRITE(1, SO);
    RESC(alA); __syncthreads();
  }
  SBAR(); qkt(pB0, pB1, K_lds + SHM_K, qr, r32, hi);
  finishSM(pA0, pA1, alA, l_reg, pa0, pa1, pa2, pa3); SBAR();
  pv_d0(o, vb0, pa0, pa1, pa2, pa3); na_bias<NA>(pB0, pB1, NT - 1, u, rgrid, rs, cs, hi, lrow); partialSM(pB0, pB1, m_reg, mnB, alB);
  __syncthreads(); RESC(alB);
  finishSM(pB0, pB1, alB, l_reg, pa0, pa1, pa2, pa3); SBAR();
  pv_d0(o, vb0 + SHM_V, pa0, pa1, pa2, pa3);
  if (hi == 0) li_l[r32] = l_reg; asm volatile("s_waitcnt lgkmcnt(0)" ::: "memory");
  float rli[16];
#pragma unroll
  for (int r = 0; r < 16; ++r) rli[r] = __builtin_amdgcn_rcpf(li_l[crow(r, hi)]);
  char* st = lds + ST_OFF + wid * ST_WAVE;
#pragma unroll
  for (int r = 0; r < 16; ++r) { const int orow = crow(r, hi);
#pragma unroll
    for (int d0 = 0; d0 < 4; ++d0) { const float v = o[d0][r] * rli[r]; unsigned b = __float_as_uint(v); b = (b + 0x7fffu + ((b >> 16) & 1u)) >> 16;
      *(bf16_t*)(st + orow * ST_PITCH + (d0 * 32 + r32) * 2) = (bf16_t)b; } }
  asm volatile("s_waitcnt lgkmcnt(0)" ::: "memory");
  gbf* Ow = u.O + (long)(wid * QBLK) * u.ldo;
#pragma unroll
  for (int q = 0; q < 8; ++q) { const int idx = q * 64 + lane, orow = idx >> 4, ch = idx & 15;
    const u32x4 w = *(const u32x4*)(st + orow * ST_PITCH + ch * 16);
    *(ATT_GAS u32x4*)(Ow + (long)orow * u.ldo + ch * 8) = w; }
  asm volatile("s_waitcnt lgkmcnt(0)" ::: "memory");
#undef KTILE
#undef SLOAD
#undef SWRITE
#undef SWAIT
#undef RESC
}

template <int D0> __device__ __forceinline__ void pv_one_b(f32x16& od, const ATT_LAS char* vp, bf16x8 pa0, bf16x8 pa1, bf16x8 pa2, bf16x8 pa3) {
#define TRB(off) __builtin_amdgcn_ds_read_tr16_b64_v4i16((ATT_LAS s16x4*)(vp + (off)))
  const s16x4 l0 = TRB(v_rd_off(D0, 0, 0)), h0 = TRB(v_rd_off(D0, 0, 1)), l1 = TRB(v_rd_off(D0, 1, 0)), h1 = TRB(v_rd_off(D0, 1, 1));
  const s16x4 l2 = TRB(v_rd_off(D0, 2, 0)), h2 = TRB(v_rd_off(D0, 2, 1)), l3 = TRB(v_rd_off(D0, 3, 0)), h3 = TRB(v_rd_off(D0, 3, 1));
#undef TRB
#define PK(L, H) (bf16x8){L[0], L[1], L[2], L[3], H[0], H[1], H[2], H[3]}
  od = __builtin_amdgcn_mfma_f32_32x32x16_bf16(pa0, PK(l0, h0), od, 0, 0, 0);
  od = __builtin_amdgcn_mfma_f32_32x32x16_bf16(pa1, PK(l1, h1), od, 0, 0, 0);
  od = __builtin_amdgcn_mfma_f32_32x32x16_bf16(pa2, PK(l2, h2), od, 0, 0, 0);
  od = __builtin_amdgcn_mfma_f32_32x32x16_bf16(pa3, PK(l3, h3), od, 0, 0, 0);
#undef PK
}
__device__ __forceinline__ void pv_d0_b(f32x16* o, const ATT_LAS char* vp, bf16x8 pa0, bf16x8 pa1, bf16x8 pa2, bf16x8 pa3) {
  pv_one_b<0>(o[0], vp, pa0, pa1, pa2, pa3); pv_one_b<1>(o[1], vp, pa0, pa1, pa2, pa3); pv_one_b<2>(o[2], vp, pa0, pa1, pa2, pa3); pv_one_b<3>(o[3], vp, pa0, pa1, pa2, pa3);
}
#ifndef ATT_WPV
#define ATT_WPV 0
#endif
#ifndef ATT_WQK
#define ATT_WQK 0
#endif
#ifndef ATT_WPROBE
#define ATT_WPROBE 0
#endif
__device__ __forceinline__ void qkt_w(f32x16& p0, f32x16& p1, const ATT_LAS char* Kb, const int* ka, const bf16x8* qr) {
#define KLD(d0, up) (*(const ATT_LAS bf16x8*)(Kb + ka[(d0) & 3] + ((d0) >> 2) * 128 + (up) * 8192))
  p0 = f32x16{}; p1 = f32x16{};
  bf16x8 a0 = KLD(0, 0), a1 = KLD(0, 1), b0 = KLD(1, 0), b1 = KLD(1, 1);
#pragma unroll
  for (int d0 = 0; d0 < 8; d0 += 2) {
    p0 = __builtin_amdgcn_mfma_f32_32x32x16_bf16(a0, qr[d0], p0, 0, 0, 0);
    p1 = __builtin_amdgcn_mfma_f32_32x32x16_bf16(a1, qr[d0], p1, 0, 0, 0);
    if (d0 + 2 < 8) { a0 = KLD(d0 + 2, 0); a1 = KLD(d0 + 2, 1); }
    p0 = __builtin_amdgcn_mfma_f32_32x32x16_bf16(b0, qr[d0 + 1], p0, 0, 0, 0);
    p1 = __builtin_amdgcn_mfma_f32_32x32x16_bf16(b1, qr[d0 + 1], p1, 0, 0, 0);
    if (d0 + 3 < 8) { b0 = KLD(d0 + 3, 0); b1 = KLD(d0 + 3, 1); }
  }
  __builtin_amdgcn_sched_group_barrier(0x100, 4, 0);
#pragma unroll
  for (int i = 0; i < 6; ++i) { __builtin_amdgcn_sched_group_barrier(0x008, 2, 0); __builtin_amdgcn_sched_group_barrier(0x100, 2, 0); }
  __builtin_amdgcn_sched_group_barrier(0x008, 4, 0);
#undef KLD
}
struct VF { s16x4 l0, h0, l1, h1, l2, h2, l3, h3; };
template <int DB> __device__ __forceinline__ void pvw_read(VF& f, int vb) {
  constexpr int B = (DB >> 2) * SHM_V, D0 = DB & 3;
  f.l0 = tr_read<B + v_rd_off(D0, 0, 0)>(vb); f.h0 = tr_read<B + v_rd_off(D0, 0, 1)>(vb); f.l1 = tr_read<B + v_rd_off(D0, 1, 0)>(vb); f.h1 = tr_read<B + v_rd_off(D0, 1, 1)>(vb);
  f.l2 = tr_read<B + v_rd_off(D0, 2, 0)>(vb); f.h2 = tr_read<B + v_rd_off(D0, 2, 1)>(vb); f.l3 = tr_read<B + v_rd_off(D0, 3, 0)>(vb); f.h3 = tr_read<B + v_rd_off(D0, 3, 1)>(vb);
}
__device__ __forceinline__ void pvw_mma(f32x16& od, const VF& f, bf16x8 pa0, bf16x8 pa1, bf16x8 pa2, bf16x8 pa3) {
#define PK(L, H) (bf16x8){L[0], L[1], L[2], L[3], H[0], H[1], H[2], H[3]}
  od = __builtin_amdgcn_mfma_f32_32x32x16_bf16(pa0, PK(f.l0, f.h0), od, 0, 0, 0);
  od = __builtin_amdgcn_mfma_f32_32x32x16_bf16(pa1, PK(f.l1, f.h1), od, 0, 0, 0);
  od = __builtin_amdgcn_mfma_f32_32x32x16_bf16(pa2, PK(f.l2, f.h2), od, 0, 0, 0);
  od = __builtin_amdgcn_mfma_f32_32x32x16_bf16(pa3, PK(f.l3, f.h3), od, 0, 0, 0);
#undef PK
}
__device__ __forceinline__ void pv_wide8(f32x16* o, int vb, bf16x8 pa0, bf16x8 pa1, bf16x8 pa2, bf16x8 pa3) {
  VF fa, fb;
#define W8() do { asm volatile("s_waitcnt lgkmcnt(8)" ::: "memory"); SBAR(); } while (0)
  pvw_read<0>(fa, vb);
  pvw_read<1>(fb, vb); W8(); pvw_mma(o[0], fa, pa0, pa1, pa2, pa3); SBAR();
  pvw_read<2>(fa, vb); W8(); pvw_mma(o[1], fb, pa0, pa1, pa2, pa3); SBAR();
  pvw_read<3>(fb, vb); W8(); pvw_mma(o[2], fa, pa0, pa1, pa2, pa3); SBAR();
  pvw_read<4>(fa, vb); W8(); pvw_mma(o[3], fb, pa0, pa1, pa2, pa3); SBAR();
  pvw_read<5>(fb, vb); W8(); pvw_mma(o[4], fa, pa0, pa1, pa2, pa3); SBAR();
  pvw_read<6>(fa, vb); W8(); pvw_mma(o[5], fb, pa0, pa1, pa2, pa3); SBAR();
  pvw_read<7>(fb, vb); W8(); pvw_mma(o[6], fa, pa0, pa1, pa2, pa3); SBAR();
  asm volatile("s_waitcnt lgkmcnt(0)" ::: "memory"); SBAR(); pvw_mma(o[7], fb, pa0, pa1, pa2, pa3);
#undef W8
}
constexpr int W_K = 0, W_V = 2 * SHM_K, W_VBUF = 2 * SHM_V, W_WS = W_V + 2 * W_VBUF, W_LDS_BYTES = W_WS + NW * 64 * 4;
__device__ __forceinline__ void attn_wide_unit(const Unit& u, char* lds) {
  int tid_ = threadIdx.x; asm volatile("" : "+v"(tid_));
  const int tid = tid_, wid = __builtin_amdgcn_readfirstlane(tid >> 6), lane = tid & 63, r32 = lane & 31, hi = lane >> 5;
  float* ws = (float*)(lds + W_WS) + wid * 64; float* li_l = ws; float* al_l = ws + 32;
  float m_reg = -1e30f, l_reg = 0; f32x16 o[8] = {}; bf16x8 qr[8];
  const gbf* Qw = u.Q + (long)(wid * QBLK + r32) * LDP + hi * 8;
#pragma unroll
  for (int d0 = 0; d0 < 8; ++d0) qr[d0] = *(const gbf8*)(Qw + d0 * 16);
  const int kr0 = wid * 8 + (lane >> 4);
  const unsigned offK0 = (unsigned)(kr0 * LDP + (((lane & 15) ^ (lane >> 4)) * 8)), offK1 = (unsigned)((kr0 + 4) * LDP + (((lane & 15) ^ (4 + (lane >> 4))) * 8));
  const int vkk = wid * 8 + ((lane & 31) >> 2), vk = (vkk & ~0xC) | ((vkk & 4) << 1) | ((vkk & 8) >> 1);
  const unsigned offV = (unsigned)(vk * LDP + (lane >> 5) * 32 + (lane & 3) * 8);
  const int vb0 = (int)(uintptr_t)(lds + W_V) + v_rd_base(lane);
  ATT_LAS unsigned char* l3 = (ATT_LAS unsigned char*)lds;
  const ATT_LAS char* vp0 = (const ATT_LAS char*)l3 + W_V + v_rd_base(lane);
  int ka[4];
#pragma unroll
  for (int dd = 0; dd < 4; ++dd) ka[dd] = r32 * 256 + ((dd * 32 + hi * 16) ^ ((r32 & 7) << 4));
#define KTILE(j) ((j) < u.n0 ? u.K0 + (size_t)(j) * (KVBLK * LDP) : u.K1 + (size_t)((j) - u.n0) * (KVBLK * LDP))
#define WDMA(gp, loff) __builtin_amdgcn_global_load_lds((const ATT_GAS unsigned*)(gp), (ATT_LAS unsigned*)(l3 + (loff)), 16, 0, 0)
#define WISSUE(j, b) do { const gbf* kt_ = KTILE(j); const gbf* vt_ = kt_ + u.dv + offV; \
    WDMA(kt_ + offK0, W_K + (b) * SHM_K + wid * 2048); WDMA(kt_ + offK1, W_K + (b) * SHM_K + wid * 2048 + 1024); \
    WDMA(vt_, W_V + (b) * W_VBUF + wid * 2048); WDMA(vt_ + 64, W_V + (b) * W_VBUF + wid * 2048 + 1024); \
    WDMA(vt_ + 128, W_V + (b) * W_VBUF + SHM_V + wid * 2048); WDMA(vt_ + 192, W_V + (b) * W_VBUF + SHM_V + wid * 2048 + 1024); } while (0)
#define WRESC(a) do { if (__any((a) < 1.f)) { if (hi == 0) al_l[r32] = (a); asm volatile("s_waitcnt lgkmcnt(0)" ::: "memory"); \
    _Pragma("unroll") for (int d = 0; d < 8; ++d) _Pragma("unroll") for (int r = 0; r < 16; ++r) o[d][r] *= al_l[crow(r, hi)]; } } while (0)
#define WSTEP(j, b) do { f32x16 p0, p1; float mn, al; bf16x8 pa0, pa1, pa2, pa3; \
    if ((j) + 1 < NT) WISSUE((j) + 1, 1 - (b)); \
    if (ATT_WPROBE == 1) { qkt_w(p0, p1, (const ATT_LAS char*)l3 + W_K + (b) * SHM_K, ka, qr); asm volatile("" : "+v"(p0), "+v"(p1)); } \
    if (ATT_WQK) qkt_w(p0, p1, (const ATT_LAS char*)l3 + W_K + (b) * SHM_K, ka, qr); else qkt(p0, p1, lds + W_K + (b) * SHM_K, qr, r32, hi); partialSM(p0, p1, m_reg, mn, al); WRESC(al); finishSM(p0, p1, al, l_reg, pa0, pa1, pa2, pa3); SBAR(); \
    if (ATT_WPROBE == 2) { pv_wide8(o, vb0 + (b) * W_VBUF, pa0, pa1, pa2, pa3); _Pragma("unroll") for (int i_ = 0; i_ < 8; ++i_) asm volatile("" : "+v"(o[i_])); \
      bf16x8 n0 = pa0 ^ (short)0x8000, n1 = pa1 ^ (short)0x8000, n2 = pa2 ^ (short)0x8000, n3 = pa3 ^ (short)0x8000; pv_wide8(o, vb0 + (b) * W_VBUF, n0, n1, n2, n3); _Pragma("unroll") for (int i_ = 0; i_ < 8; ++i_) asm volatile("" : "+v"(o[i_])); } \
    if (ATT_WPV == 2) pv_wide8(o, vb0 + (b) * W_VBUF, pa0, pa1, pa2, pa3); \
    else if (ATT_WPV) { pv_d0_b(o, vp0 + (b) * W_VBUF, pa0, pa1, pa2, pa3); pv_d0_b(o + 4, vp0 + (b) * W_VBUF + SHM_V, pa0, pa1, pa2, pa3); } \
    else { pv_d0(o, vb0 + (b) * W_VBUF, pa0, pa1, pa2, pa3); pv_d0(o + 4, vb0 + (b) * W_VBUF + SHM_V, pa0, pa1, pa2, pa3); } \
    asm volatile("s_waitcnt vmcnt(0)" ::: "memory"); __syncthreads(); } while (0)
  const int NT = u.NT;
#ifndef ATT_WPRIO
#define ATT_WPRIO 0
#endif
  if (ATT_WPRIO && wid < 4) __builtin_amdgcn_s_setprio(ATT_WPRIO);
  __syncthreads();
  WISSUE(0, 0); asm volatile("s_waitcnt vmcnt(0)" ::: "memory"); __syncthreads();
  for (int j = 0; j < NT; j += 2) { WSTEP(j, 0); WSTEP(j + 1, 1); }
  if (ATT_WPRIO) __builtin_amdgcn_s_setprio(0);
  if (hi == 0) li_l[r32] = l_reg; asm volatile("s_waitcnt lgkmcnt(0)" ::: "memory");
  float rli[16];
#pragma unroll
  for (int r = 0; r < 16; ++r) rli[r] = __builtin_amdgcn_rcpf(li_l[crow(r, hi)]);
  char* st = lds + wid * ST_WAVE;
  gbf* Ow = u.O + (long)(wid * QBLK) * u.ldo;
#pragma unroll
  for (int h = 0; h < 2; ++h) {
#pragma unroll
    for (int r = 0; r < 16; ++r) { const int orow = crow(r, hi);
#pragma unroll
      for (int d0 = 0; d0 < 4; ++d0) { const float v = o[4 * h + d0][r] * rli[r]; unsigned b = __float_as_uint(v); b = (b + 0x7fffu + ((b >> 16) & 1u)) >> 16;
        *(bf16_t*)(st + orow * ST_PITCH + (d0 * 32 + r32) * 2) = (bf16_t)b; } }
    asm volatile("s_waitcnt lgkmcnt(0)" ::: "memory");
#pragma unroll
    for (int q = 0; q < 8; ++q) { const int idx = q * 64 + lane, orow = idx >> 4, ch = idx & 15;
      const u32x4 w = *(const u32x4*)(st + orow * ST_PITCH + ch * 16);
      *(ATT_GAS u32x4*)(Ow + (long)orow * u.ldo + h * 128 + ch * 8) = w; }
    asm volatile("s_waitcnt lgkmcnt(0)" ::: "memory");
  }
#undef KTILE
#undef WDMA
#undef WISSUE
#undef WRESC
#undef WSTEP
}

constexpr int D_K = 0, D_V = 3 * SHM_K, D_WS = D_V + 3 * SHM_V, D_TBL = D_WS + NW * 64 * 4, D_LDS_BYTES = D_TBL + TBL_BYTES;
template <bool NA>
__device__ __forceinline__ void attn_dma_unit(const Unit& u, char* lds) {
  int tid_ = threadIdx.x; asm volatile("" : "+v"(tid_));
  const int tid = tid_, wid = __builtin_amdgcn_readfirstlane(tid >> 6), lane = tid & 63, r32 = lane & 31, hi = lane >> 5;
  float* ws = (float*)(lds + D_WS) + wid * 64; float* li_l = ws; float* al_l = ws + 32;
  float m_reg = -1e30f, l_reg = 0; f32x16 o[4] = {}; bf16x8 qr[8];
  const gbf* Qw = u.Q + (long)(wid * QBLK + r32) * LDP + hi * 8;
#pragma unroll
  for (int d0 = 0; d0 < 8; ++d0) qr[d0] = *(const gbf8*)(Qw + d0 * 16);
  const int kr0 = wid * 8 + (lane >> 4);
  const unsigned offK0 = (unsigned)(kr0 * LDP + (((lane & 15) ^ (lane >> 4)) * 8)), offK1 = (unsigned)((kr0 + 4) * LDP + (((lane & 15) ^ (4 + (lane >> 4))) * 8));
  const int vkk = wid * 8 + ((lane & 31) >> 2), vk = (vkk & ~0xC) | ((vkk & 4) << 1) | ((vkk & 8) >> 1);
  const unsigned offV = (unsigned)(vk * LDP + (lane >> 5) * 32 + (lane & 3) * 8);
  const int vb0 = (int)(uintptr_t)(lds + D_V) + v_rd_base(lane);
  ATT_LAS unsigned char* l3 = (ATT_LAS unsigned char*)lds;
  const int rgrid = u.r0 + (wid >> 1), rs = rgrid - 4 < 0 ? 0 : (rgrid - 4 > 24 ? 24 : rgrid - 4);
  const int qc = (wid & 1) * 32 + r32, cs = qc - 8 < 0 ? 0 : (qc - 8 > 48 ? 48 : qc - 8);
  const float* lrow = (const float*)(lds + D_TBL) + (48 + 4 * hi - qc + 15);
#define KTILE(j) ((j) < u.n0 ? u.K0 + (size_t)(j) * (KVBLK * LDP) : u.K1 + (size_t)((j) - u.n0) * (KVBLK * LDP))
#define WDMA(gp, loff) __builtin_amdgcn_global_load_lds((const ATT_GAS unsigned*)(gp), (ATT_LAS unsigned*)(l3 + (loff)), 16, 0, 0)
#define DISSUE(j, bo) do { const gbf* kt_ = KTILE(j); const gbf* vt_ = kt_ + u.dv + offV; \
    WDMA(kt_ + offK0, D_K + (bo) + wid * 2048); WDMA(kt_ + offK1, D_K + (bo) + wid * 2048 + 1024); \
    WDMA(vt_, D_V + (bo) + wid * 2048); WDMA(vt_ + 64, D_V + (bo) + wid * 2048 + 1024); } while (0)
#define DRESC(a) do { if (__any((a) < 1.f)) { if (hi == 0) al_l[r32] = (a); asm volatile("s_waitcnt lgkmcnt(0)" ::: "memory"); \
    _Pragma("unroll") for (int d = 0; d < 4; ++d) _Pragma("unroll") for (int r = 0; r < 16; ++r) o[d][r] *= al_l[crow(r, hi)]; } } while (0)
  f32x16 pA0, pA1, pB0, pB1; float mnA, mnB, alA, alB; bf16x8 pa0, pa1, pa2, pa3; const int NT = u.NT;
  int b0 = 0, b1 = SHM_K, b2 = 2 * SHM_K;
  __syncthreads();
  DISSUE(0, b0); DISSUE(1, b1);
  asm volatile("s_waitcnt vmcnt(4)" ::: "memory"); __syncthreads();
  qkt(pA0, pA1, lds + D_K + b0, qr, r32, hi); na_bias<NA>(pA0, pA1, 0, u, rgrid, rs, cs, hi, lrow); partialSM(pA0, pA1, m_reg, mnA, alA);
  asm volatile("s_waitcnt vmcnt(0)" ::: "memory"); __syncthreads();
#define DVALID(j) (!NA || (j) < u.n0 || (((j) - u.n0) < u.ntl && (unsigned)(u.kr_lo + ((j) - u.n0) - rs) < 8u))
  bool vA = true, vB;
  for (int j = 0; j < NT; j += 2) {
    if (j + 2 < NT) DISSUE(j + 2, b2);
    vB = DVALID(j + 1);
    if (vB) { SBAR(); qkt(pB0, pB1, lds + D_K + b1, qr, r32, hi); }
    if (vA) { finishSM(pA0, pA1, alA, l_reg, pa0, pa1, pa2, pa3); SBAR();
      pv_d0(o, vb0 + b0, pa0, pa1, pa2, pa3); }
    if (vB) { na_bias<NA>(pB0, pB1, j + 1, u, rgrid, rs, cs, hi, lrow); partialSM(pB0, pB1, m_reg, mnB, alB);
      DRESC(alB); }
    asm volatile("s_waitcnt vmcnt(0)" ::: "memory"); __syncthreads();
    if (j + 3 < NT) DISSUE(j + 3, b0);
    vA = (j + 2 < NT) && DVALID(j + 2);
    if (vA) { SBAR(); qkt(pA0, pA1, lds + D_K + b2, qr, r32, hi); }
    if (vB) { finishSM(pB0, pB1, alB, l_reg, pa0, pa1, pa2, pa3); SBAR();
      pv_d0(o, vb0 + b1, pa0, pa1, pa2, pa3); }
    if (vA) { na_bias<NA>(pA0, pA1, j + 2, u, rgrid, rs, cs, hi, lrow); partialSM(pA0, pA1, m_reg, mnA, alA); DRESC(alA); }
    asm volatile("s_waitcnt vmcnt(0)" ::: "memory"); __syncthreads();
    { const int t_ = b0; b0 = b2; b2 = b1; b1 = t_; }
  }
#undef DVALID
  if (hi == 0) li_l[r32] = l_reg; asm volatile("s_waitcnt lgkmcnt(0)" ::: "memory");
  float rli[16];
#pragma unroll
  for (int r = 0; r < 16; ++r) rli[r] = __builtin_amdgcn_rcpf(li_l[crow(r, hi)]);
  char* st = lds + wid * ST_WAVE;
#pragma unroll
  for (int r = 0; r < 16; ++r) { const int orow = crow(r, hi);
#pragma unroll
    for (int d0 = 0; d0 < 4; ++d0) { const float v = o[d0][r] * rli[r]; unsigned b = __float_as_uint(v); b = (b + 0x7fffu + ((b >> 16) & 1u)) >> 16;
      *(bf16_t*)(st + orow * ST_PITCH + (d0 * 32 + r32) * 2) = (bf16_t)b; } }
  asm volatile("s_waitcnt lgkmcnt(0)" ::: "memory");
  gbf* Ow = u.O + (long)(wid * QBLK) * u.ldo;
#pragma unroll
  for (int q = 0; q < 8; ++q) { const int idx = q * 64 + lane, orow = idx >> 4, ch = idx & 15;
    const u32x4 w = *(const u32x4*)(st + orow * ST_PITCH + ch * 16);
    *(ATT_GAS u32x4*)(Ow + (long)orow * u.ldo + ch * 8) = w; }
  asm volatile("s_waitcnt lgkmcnt(0)" ::: "memory");
#undef KTILE
#undef WDMA
#undef DISSUE
#undef DRESC
}
#undef KSWZ
#undef SBAR
}
constexpr int NWAVES = 8;
constexpr int DM = 2048, NBATCH = 8, SEQ = 2048, NLAYER = 2, CTXL = 256;
constexpr int ML = NBATCH * SEQ, MC = NBATCH * CTXL, MT = ML + MC;
constexpr int DFF = 5632, DIN = 10240, QA_OFF = 4096, QB_OFF = 5120, G_OFF = 6144;
constexpr int MODW = 9 * DM;
#ifndef PAD_H
#define PAD_H 64
#endif
#ifndef PAD_U
#define PAD_U 64
#endif
constexpr int LDH = DM + PAD_H, LDU = DFF + PAD_U;
constexpr float EPS = 1e-6f;
constexpr int N_IN = 26;
enum { IN_X = 0, IN_C, IN_CTX, IN_CCTX, IN_ADAW, IN_ADAB, IN_N1G, IN_F1W1, IN_F1W3, IN_F1W2, IN_N2G, IN_WIN, IN_RPB, IN_LQ1, IN_LK1, IN_LQ2, IN_LK2, IN_SUBG, IN_WPA, IN_WPB, IN_WO, IN_N3G, IN_F2W1, IN_F2W3, IN_F2W2, IN_FG };

constexpr size_t MiB = 1u << 20;
constexpr size_t WS_CTL = 0, CTL_ZERO_BYTES = 1 * MiB;
constexpr size_t WS_MISC = 1 * MiB;
constexpr size_t WS_ROPE = 2 * MiB;
constexpr size_t WS_MOD = 3 * MiB;
constexpr size_t WS_W = 8 * MiB;
constexpr size_t WL_13A = 0, WL_2A = 46 * MiB, WL_13B = 69 * MiB, WL_2B = 115 * MiB, WL_IN = 138 * MiB, WL_PAB = 180 * MiB, WL_O = 189 * MiB, WL_SIZE = 198 * MiB;
constexpr size_t WS_X = WS_W + 2 * WL_SIZE;
constexpr size_t WS_P = WS_X + 144 * MiB;
constexpr size_t WS_Y = WS_P + 360 * MiB;
constexpr size_t WS_H = WS_Y + 75 * MiB;
constexpr size_t WS_DBG = WS_H + 75 * MiB;
constexpr size_t WS_END = WS_DBG + 8 * MiB;
static_assert(WL_13A + (size_t)2 * DFF * LDH * 2 <= WL_2A && WL_2A + (size_t)DM * LDU * 2 <= WL_13B && WL_13B + (size_t)2 * DFF * LDH * 2 <= WL_2B && WL_2B + (size_t)DM * LDU * 2 <= WL_IN && WL_IN + (size_t)DIN * LDH * 2 <= WL_PAB && WL_PAB + (size_t)DM * LDH * 2 <= WL_O && WL_O + (size_t)DM * LDH * 2 <= WL_SIZE, "weight map");
static_assert((size_t)MT * DM * 4 <= 144 * MiB && (size_t)MT * DIN * 2 <= 360 * MiB && (size_t)MT * LDU * 2 <= 360 * MiB && (size_t)MT * LDH * 2 <= 75 * MiB, "activation map");
constexpr int CW_TMO = 0, CW_CODE = 1, CW_BAR = 4096, CW_DBG = 16384;

constexpr int RING_OFF = 0, RING_BYTES = 131072;
constexpr int LDS_BYTES = 147456;
constexpr int LDSCTL_OFF = LDS_BYTES - 512, MISC_OFF = LDSCTL_OFF;
static_assert(att::ATT_LDS_BYTES <= LDSCTL_OFF && att::W_LDS_BYTES <= LDSCTL_OFF && att::D_LDS_BYTES <= LDSCTL_OFF && att::NW * att::ST_WAVE <= att::D_WS && att::NW * att::ST_WAVE <= att::W_WS, "attention LDS map");

#define GAS __attribute__((address_space(1)))
#define LAS __attribute__((address_space(3)))
typedef unsigned short bf16;
typedef unsigned v4u __attribute__((ext_vector_type(4)));
typedef unsigned v2u __attribute__((ext_vector_type(2)));
typedef float f32x4 __attribute__((ext_vector_type(4)));
typedef GAS unsigned gu32;
#define RLX_AGENT __ATOMIC_RELAXED, __HIP_MEMORY_SCOPE_AGENT
#define LDS_WAIT() asm volatile("s_waitcnt lgkmcnt(0)" ::: "memory")
#define VM_WAIT() asm volatile("s_waitcnt vmcnt(0)" ::: "memory")
__device__ __forceinline__ unsigned f2bf(float f) { unsigned u = __builtin_bit_cast(unsigned, f); return (u + 0x7fffu + ((u >> 16) & 1u)) >> 16; }
__device__ __forceinline__ unsigned pk2(float lo, float hi) { return pg8::cvt_pk_bf16(lo, hi); }
__device__ __forceinline__ float bf2f(unsigned short v) { return __uint_as_float((unsigned)v << 16); }

#define XB_TMO      128
#define XB_XCNT(j)  (256  + 64 * (j))
#define XB_XSUB(j)  (1280 + 64 * (j))
#define XB_XGEN(j)  (2304 + 64 * (j))
#define XB_TOP      3328
#define XB_TOPGEN   3392
#define XCD_BAR_WORDS 3456
#define XB_SPIN_CAP (1u << 20)
__device__ __forceinline__ unsigned xb_ld(unsigned* p)              { return __hip_atomic_load(p, __ATOMIC_RELAXED, __HIP_MEMORY_SCOPE_AGENT); }
__device__ __forceinline__ unsigned xb_add(unsigned* p, unsigned v) { return __hip_atomic_fetch_add(p, v, __ATOMIC_RELAXED, __HIP_MEMORY_SCOPE_AGENT); }
__device__ __forceinline__ unsigned xb_xcc_id() { return (unsigned)__builtin_amdgcn_s_getreg((3 << 11) | 20) & 0xFu; }
#define XB_SPIN(cond, bar) do { unsigned _sp = 0; while (cond) { __builtin_amdgcn_s_sleep(1); \
    if ((++_sp & 255u) == 0u) { if (xb_ld(&(bar)[XB_TMO])) break; if (_sp > XB_SPIN_CAP) { atomicAdd(&(bar)[XB_TMO], 1u); break; } } } } while (0)
struct XcdBarrier { unsigned* bar; unsigned x; volatile LAS unsigned* st; };
__device__ __forceinline__ XcdBarrier xcd_barrier_post(unsigned* bar, volatile LAS unsigned* st) {
    XcdBarrier b; b.bar = bar; b.x = xb_xcc_id(); b.st = st;
    if (threadIdx.x == 0) (void)xb_add(&bar[XB_XCNT(b.x)], 1u);
    return b;
}
__device__ __forceinline__ void xcd_barrier_complete(unsigned* bar, unsigned x, unsigned& nloc, unsigned& nx) {
    const unsigned G = gridDim.x * gridDim.y * gridDim.z;
    unsigned sum, cnt, mine, sp = 0u;
    for (;;) {
        sum = 0u; cnt = 0u; mine = 0u;
#pragma unroll
        for (unsigned j = 0; j < 16; ++j) { const unsigned c = xb_ld(&bar[XB_XCNT(j)]); sum += c; cnt += (c > 0u) ? 1u : 0u; mine = (j == x) ? c : mine; }
        if (sum == G) break;
        __builtin_amdgcn_s_sleep(1);
        if ((++sp & 255u) == 0u) { if (xb_ld(&bar[XB_TMO])) break; if (sp > XB_SPIN_CAP) { atomicAdd(&bar[XB_TMO], 1u); break; } }
    }
    nloc = mine > 0u ? mine : 1u; nx = cnt > 0u ? cnt : 1u;
}
__device__ __forceinline__ void xcd_barrier(const XcdBarrier& b) {
    asm volatile("s_waitcnt vmcnt(0)" ::: "memory");
    __syncthreads();
    if (threadIdx.x == 0) {
        unsigned* bar = b.bar;
        __builtin_amdgcn_s_waitcnt(0);
        unsigned nloc = b.st[0], nx = b.st[1];
        if (nloc == 0u) { xcd_barrier_complete(bar, b.x, nloc, nx); b.st[0] = nloc; b.st[1] = nx; }
        const unsigned old = xb_add(&bar[XB_XSUB(b.x)], 1u);
        const unsigned gen = old / nloc;
        if (old + 1u == (gen + 1u) * nloc) {
            __builtin_amdgcn_fence(__ATOMIC_RELEASE, "agent");
            asm volatile("s_waitcnt vmcnt(0)" ::: "memory");
            const unsigned og = xb_add(&bar[XB_TOP], 1u);
            const unsigned tg = og / nx;
            if (og + 1u == (tg + 1u) * nx) xb_add(&bar[XB_TOPGEN], 1u);
            else XB_SPIN(xb_ld(&bar[XB_TOPGEN]) == tg, bar);
            __builtin_amdgcn_fence(__ATOMIC_ACQUIRE, "agent");
            xb_add(&bar[XB_XGEN(b.x)], 1u);
            asm volatile("s_waitcnt vmcnt(0)" ::: "memory");
        } else {
            XB_SPIN(xb_ld(&bar[XB_XGEN(b.x)]) == gen, bar);
            __builtin_amdgcn_fence(__ATOMIC_ACQUIRE, "agent");
            asm volatile("s_waitcnt vmcnt(0)" ::: "memory");
        }
    }
    __syncthreads();
}

__device__ __forceinline__ float wave_sum(float v) {
#pragma unroll
    for (int o = 1; o < 64; o <<= 1) v += __shfl_xor(v, o);
    return v;
}

__host__ __device__ __forceinline__ int w13_row(int j, int is3) { return 256 * (j >> 7) + 128 * ((j >> 2) & 1) + 32 * ((j >> 5) & 3) + 16 * is3 + 4 * ((j >> 3) & 3) + (j & 3); }
__host__ __device__ __forceinline__ int win_row(int j) {
    if (!((j >= 2048 && j < 3072) || (j >= 5120 && j < 6144))) return j;
    const int d = j & 127, a = d >> 6, h = (d >> 5) & 1, f = d & 31;
    return (j & ~127) + 32 * (2 * a + (f >> 4)) + 8 * ((f >> 2) & 3) + 4 * h + (f & 3);
}
__device__ __forceinline__ void tr_item(const GAS float* W, int N, int k0, int n0, GAS bf16* WT, int ldk, int koff, int mode, LAS float* scr, int lane) {
    f32x4 v[16];
    const GAS f32x4* src = (const GAS f32x4*)(W + (size_t)(k0 + (lane >> 4)) * N + n0 + 4 * (lane & 15));
#pragma unroll
    for (int i = 0; i < 16; ++i) v[i] = __builtin_nontemporal_load(src + (size_t)i * N);
#pragma unroll
    for (int i = 0; i < 16; ++i) { LAS float* d = scr + (4 * i + (lane >> 4)) * 65 + 4 * (lane & 15); d[0] = v[i].x; d[1] = v[i].y; d[2] = v[i].z; d[3] = v[i].w; }
    LDS_WAIT(); asm volatile("" ::: "memory");
    const int c = lane & 7;
#pragma unroll
    for (int j = 0; j < 8; ++j) { const int n = (lane >> 3) + 8 * j; const LAS float* s = scr + (8 * c) * 65 + n;
        v4u o; o.x = pk2(s[0 * 65], s[1 * 65]); o.y = pk2(s[2 * 65], s[3 * 65]); o.z = pk2(s[4 * 65], s[5 * 65]); o.w = pk2(s[6 * 65], s[7 * 65]);
        const int col = n0 + n, row = mode == 0 ? col : (mode == 3 ? win_row(col) : w13_row(col, mode - 1));
        __builtin_nontemporal_store(o, (GAS v4u*)(WT + (size_t)row * ldk + koff + k0 + 8 * c)); }
    LDS_WAIT(); asm volatile("" ::: "memory");
}
__device__ __forceinline__ void norm_row(const GAS float* xrow, const GAS float* g, const GAS float* shift, const GAS float* scale, GAS bf16* hrow,
                                         const GAS float* sl, const GAS float* gate, float gs, GAS float* xw, int lane) {
    const GAS f32x4* xr = (const GAS f32x4*)xrow + lane;
    const GAS f32x4* gp = (const GAS f32x4*)g + lane; const GAS f32x4* shp = (const GAS f32x4*)shift + lane; const GAS f32x4* scp = (const GAS f32x4*)scale + lane;
    f32x4 v[8], gs8[8], sh8[8]; float ss = 0.f;
#pragma unroll
    for (int j = 0; j < 8; ++j) v[j] = xr[64 * j];
#pragma unroll
    for (int j = 0; j < 8; ++j) { gs8[j] = gp[64 * j] * (scp[64 * j] + 1.0f); sh8[j] = shp[64 * j]; }
    if (sl) {
        const GAS v2u* s0 = (const GAS v2u*)sl + lane; const GAS f32x4* gt = (const GAS f32x4*)gate + lane; GAS f32x4* xo = (GAS f32x4*)xw + lane;
#pragma unroll
        for (int j = 0; j < 8; ++j) { f32x4 p = (f32x4){0.f, 0.f, 0.f, 0.f};
#pragma unroll
            for (int q = 0; q < 4; ++q) { const v2u w = s0[64 * j + q * (2048 * 2048 / 4)]; p.x += pg8::bf_lo(w.x); p.y += pg8::bf_hi(w.x); p.z += pg8::bf_lo(w.y); p.w += pg8::bf_hi(w.y); }
            v[j] = v[j] + gt[64 * j] * gs * p; xo[64 * j] = v[j]; }
    }
#pragma unroll
    for (int j = 0; j < 8; ++j) ss += (v[j].x * v[j].x + v[j].y * v[j].y) + (v[j].z * v[j].z + v[j].w * v[j].w);
    const float rstd = 1.0f / sqrtf(wave_sum(ss) * (1.0f / DM) + EPS);
    GAS v2u* o8 = (GAS v2u*)hrow + lane;
#pragma unroll
    for (int j = 0; j < 8; ++j) { const f32x4 y = v[j] * rstd * gs8[j] + sh8[j];
        v2u w; w.x = pk2(y.x, y.y); w.y = pk2(y.z, y.w); o8[64 * j] = w; }
}

constexpr int CV_F = 32 * 88, CV_IN = 32 * 160, CV_P = 16 * 32, CV_O = 32 * 32, CV_A = 3 * CV_F, CV_M = CV_IN + 2 * CV_P + CV_O, CV_L = 2 * CV_A + CV_M, CV_TOTAL = 2 * CV_L;
#define GIN(k) ((const GAS float*)args.in[k])
constexpr int CW_Q = 8192;
struct Args;
__device__ __forceinline__ void conv_item(const Args& args, GAS unsigned char* ws, int it, LAS float* scr, int lane);
struct Args { const float* in[N_IN]; float* out; unsigned char* ws; int ph_lo, ph_hi; };

__device__ __forceinline__ void conv_item(const Args& args, GAS unsigned char* ws, int it, LAS float* scr, int lane) {
    const int l = it / CV_L; int r = it % CV_L;
    GAS unsigned char* wl = ws + WS_W + (size_t)l * WL_SIZE;
    int f = 0;
    if (r >= CV_A && r < CV_A + CV_M) {
        r -= CV_A;
        if (r < CV_IN) { tr_item(GIN(IN_WIN) + (size_t)l * DM * DIN, DIN, 64 * (r / 160), 64 * (r % 160), (GAS bf16*)(wl + WL_IN), LDH, 0, 3, scr, lane); return; }
        r -= CV_IN;
        if (r < 2 * CV_P) { const int which = r / CV_P, idx = r % CV_P;
            tr_item(GIN(IN_WPA + which) + (size_t)l * 1024 * DM, DM, 64 * (idx / 32), 64 * (idx % 32), (GAS bf16*)(wl + WL_PAB), LDH, 1024 * which, 0, scr, lane); return; }
        r -= 2 * CV_P;
        tr_item(GIN(IN_WO) + (size_t)l * DM * DM, DM, 64 * (r / 32), 64 * (r % 32), (GAS bf16*)(wl + WL_O), LDH, 0, 0, scr, lane); return; }
    if (r >= CV_A) { r -= CV_A + CV_M; f = 1; }
    const int mat = r / CV_F, idx = r % CV_F;
    if (mat < 2) { const GAS float* W = GIN((f == 0 ? IN_F1W1 : IN_F2W1) + mat) + (size_t)l * DM * DFF;
        tr_item(W, DFF, 64 * (idx / 88), 64 * (idx % 88), (GAS bf16*)(wl + (f == 0 ? WL_13A : WL_13B)), LDH, 0, 1 + mat, scr, lane); }
    else { const GAS float* W = GIN(f == 0 ? IN_F1W2 : IN_F2W2) + (size_t)l * DFF * DM;
        tr_item(W, DM, 64 * (idx / 32), 64 * (idx % 32), (GAS bf16*)(wl + (f == 0 ? WL_2A : WL_2B)), LDU, 0, 0, scr, lane); }
}
__device__ __forceinline__ void conv_fill(const Args& args, GAS unsigned char* ws, LAS unsigned char* lds, volatile LAS unsigned* MISC, int max_pops, int need, int wave, int lane) {
    gu32* qh = (gu32*)(ws + WS_CTL) + CW_Q;
    LAS float* scr = (LAS float*)(lds + wave * (64 * 65 * 4));
    for (int p = 0; need > 0 || p < max_pops; ++p) {
        __syncthreads();
        if (threadIdx.x == 0) { unsigned b;
            if (need > 0 && (int)(CV_A + __hip_atomic_load(qh, RLX_AGENT)) >= need) b = 0x7fffffffu; else b = __hip_atomic_fetch_add(qh, 16u, RLX_AGENT);
            MISC[16] = b; }
        __syncthreads();
        const unsigned b = MISC[16];
        if (b >= (unsigned)(CV_TOTAL - CV_A)) break;
#pragma unroll 1
        for (int q = 0; q < 2; ++q) { const int it = CV_A + (int)b + 2 * wave + q; if (it < CV_TOTAL) conv_item(args, ws, it, scr, lane); }
        if (need > 0 && CV_A + (int)b + 16 >= need) break;
    }
    __syncthreads();
}
constexpr int N_PHASES = 24;
#ifndef PH_MASK
#define PH_MASK 0xFFFFFF
#endif
#ifndef WGM_UP
#define WGM_UP 4
#endif
#ifndef WGM_DOWN
#define WGM_DOWN 4
#endif
#ifndef WGM_IN
#define WGM_IN 4
#endif
#ifndef WGM_M1
#define WGM_M1 4
#endif
#ifndef WGM_M2
#define WGM_M2 4
#endif
#ifndef ATT_WIDE
#define ATT_WIDE 1
#endif
#ifndef ATT_DMA
#define ATT_DMA 1
#endif
#ifndef ROT_DOWN
#define ROT_DOWN 0
#endif
#ifndef NA_SD
#define NA_SD 1
#endif
#ifndef FILL_UP
#define FILL_UP 4
#endif
#ifndef FILL_IN
#define FILL_IN 4
#endif
#ifndef FILL_M1
#define FILL_M1 6
#endif

__global__ void __launch_bounds__(NWAVES * 64, 2) mega_fwd(Args args) {
    extern __shared__ __attribute__((aligned(16))) unsigned char lds_raw[];
    LAS unsigned char* lds = (LAS unsigned char*)lds_raw;
    volatile LAS unsigned* MISC = (volatile LAS unsigned*)(lds + MISC_OFF);
    const int tid0 = threadIdx.x;
    for (int u = tid0; u < (LDS_BYTES - LDSCTL_OFF) / 4; u += NWAVES * 64) ((LAS unsigned*)(lds + LDSCTL_OFF))[u] = 0u;
    __syncthreads();
    const int lo = args.ph_lo, hi = args.ph_hi;
    if (hi - lo > 1) (void)xcd_barrier_post((unsigned*)((gu32*)(args.ws + WS_CTL) + CW_BAR), MISC + 8);
    int ph = 0, li = 0;
#define IN_PH() (lo <= ph && ph < hi)
#define END_PH() do { if (ph + 1 < hi && lo <= ph) { XcdBarrier bar_; bar_.bar = (unsigned*)((gu32*)(args.ws + WS_CTL) + CW_BAR); bar_.x = xb_xcc_id(); bar_.st = MISC + 8; xcd_barrier(bar_); } ++ph; \
    asm volatile("" : "+s"(ph), "+s"(li)); } while (0)
#define PH_VIEWS() GAS unsigned char* ws = (GAS unsigned char*)args.ws; asm volatile("" : "+s"(ws)); const int G = gridDim.x, bx = blockIdx.x; int tid = threadIdx.x; asm volatile("" : "+v"(tid)); \
    const int lane = tid & 63, wave = __builtin_amdgcn_readfirstlane(tid >> 6); (void)lane; \
    const int vcu = (G % 8 == 0) ? (bx % 8) * (G / 8) + bx / 8 : bx; const int gw = vcu * NWAVES + wave, NGW = G * NWAVES; (void)gw; (void)NGW; \
    GAS float* miscf = (GAS float*)(ws + WS_MISC); GAS float* ropeC = (GAS float*)(ws + WS_ROPE); GAS float* ropeS = ropeC + 2048 * 64; GAS float* modv = (GAS float*)(ws + WS_MOD); GAS float* X = (GAS float*)(ws + WS_X); \
    GAS bf16* P = (GAS bf16*)(ws + WS_P); GAS bf16* U = P; GAS bf16* Y = (GAS bf16*)(ws + WS_Y); GAS bf16* H = (GAS bf16*)(ws + WS_H); GAS bf16* O = H; GAS bf16* Z = H; \
    (void)miscf; (void)ropeC; (void)ropeS; (void)modv; (void)X; (void)P; (void)U; (void)Y; (void)H; (void)O; (void)Z;
#define LI_VIEWS() const int l = li >> 1, f = li & 1; const bool ctx_on = (li < 3); const GAS float* modl = modv + (size_t)l * 9 * MODW; const GAS unsigned char* wl = ws + WS_W + (size_t)l * WL_SIZE; \
    const GAS float* xinL = (li == 0) ? GIN(IN_X) : X; const GAS float* xinC = (li == 0) ? GIN(IN_CTX) : X + (size_t)ML * DM; const bool ctx_q = (l == 0); \
    (void)f; (void)ctx_on; (void)modl; (void)wl; (void)xinL; (void)xinC; (void)ctx_q;

#ifndef P0_REP
#define P0_REP 1
#endif
    if (IN_PH() && (PH_MASK & 1)) for (int p0rep_ = 0; p0rep_ < P0_REP; ++p0rep_) {
        PH_VIEWS();
        __syncthreads();
        {
            LAS float* S = (LAS float*)lds;
            LAS float* PART = (LAS float*)(lds + 9 * 2048 * 4);
            const GAS float* cin = GIN(IN_C); const GAS float* ccx = GIN(IN_CCTX);
            for (int i = tid; i < 9 * 2048; i += NWAVES * 64) { const int r = i >> 11, k = i & 2047; const float v = r < 8 ? cin[r * 2048 + k] : ccx[k]; S[i] = v / (1.0f + __expf(-v)); }
            __syncthreads();
            for (int chunk = bx; chunk < 256; chunk += G) {
                const int l = chunk >> 7, n0 = (chunk & 127) * 144, col4 = tid % 36, kph = tid / 36;
                float acc[9][4];
#pragma unroll
                for (int r = 0; r < 9; ++r)
#pragma unroll
                    for (int e = 0; e < 4; ++e) acc[r][e] = 0.f;
                if (kph < 14) {
                    const GAS float* w = GIN(IN_ADAW) + (size_t)l * 2048 * MODW + n0 + 4 * col4;
#pragma unroll 4
                    for (int k = kph; k < 2048; k += 14) { const f32x4 wv = *(const GAS f32x4*)(w + (size_t)k * MODW);
#pragma unroll
                        for (int r = 0; r < 9; ++r) { const float s = S[r * 2048 + k]; acc[r][0] += s * wv.x; acc[r][1] += s * wv.y; acc[r][2] += s * wv.z; acc[r][3] += s * wv.w; } }
#pragma unroll
                    for (int r = 0; r < 9; ++r)
#pragma unroll
                        for (int e = 0; e < 4; ++e) PART[(kph * 9 + r) * 144 + 4 * col4 + e] = acc[r][e];
                }
                __syncthreads();
                for (int o = tid; o < 9 * 144; o += NWAVES * 64) { const int r = o / 144, cc = o % 144; float s = 0.f;
#pragma unroll
                    for (int q = 0; q < 14; ++q) s += PART[(q * 9 + r) * 144 + cc];
                    modv[((size_t)l * 9 + r) * MODW + n0 + cc] = s + GIN(IN_ADAB)[l * MODW + n0 + cc]; }
                __syncthreads();
            }
        }
        for (int i = bx * NWAVES * 64 + tid; i < 2048 * 64; i += G * NWAVES * 64) { const int t = i >> 6, a = (i >> 5) & 1, f = i & 31;
            const float pos = (float)(a == 0 ? (t >> 6) : (t & 63)); const float inv = powf(10000.0f, -(float)f * (1.0f / 32.0f)); const float ang = pos * inv;
            ropeC[i] = cosf(ang); ropeS[i] = sinf(ang); }
        if (bx == 0 && wave < 2) { const int l = wave;
            const GAS float* q1 = GIN(IN_LQ1) + l * 128; const GAS float* k1 = GIN(IN_LK1) + l * 128; const GAS float* q2 = GIN(IN_LQ2) + l * 128; const GAS float* k2 = GIN(IN_LK2) + l * 128;
            const float s1 = wave_sum(q1[lane] * k1[lane] + q1[lane + 64] * k1[lane + 64]), s2 = wave_sum(q2[lane] * k2[lane] + q2[lane + 64] * k2[lane + 64]);
            const float lam_init = l == 0 ? 0.2f : (0.8f - 0.6f * 0.7408182206817179f);
            if (lane == 0) miscf[l] = expf(s1) - expf(s2) + lam_init; }
        {
            LAS float* scr = (LAS float*)(lds + wave * (64 * 65 * 4));
            for (int it = gw; it < CV_A; it += NGW) conv_item(args, ws, it, scr, lane);
        }
    }
    END_PH();

    for (li = 0; li < 4; ++li) {
        if (IN_PH() && (PH_MASK & 2)) {
            PH_VIEWS(); LI_VIEWS();
            if (li > 0) conv_fill(args, ws, lds, MISC, 0, li == 1 ? CV_L : (li == 2 ? CV_L + CV_A : 2 * CV_L), wave, lane);
            const GAS float* g = GIN(f == 0 ? IN_N1G : IN_N3G) + l * DM; const int jsh = f == 0 ? 0 : 6;
            const int nrows = ctx_on ? MT : ML;
            const bool slab_on = (li == 1 || li == 2); const GAS float* sgate = modv + (size_t)8 * MODW + (li == 1 ? 5 : 8) * DM; const float sgs = li == 1 ? 1.0f : 0.5f;
            for (int row = gw; row < nrows; row += NGW) {
                const int r = row < ML ? row >> 11 : 8; const bool sl = slab_on && row >= ML;
                const GAS float* xrow = row < ML ? xinL + (size_t)row * DM : xinC + (size_t)(row - ML) * DM;
                const GAS float* shp = modl + (size_t)r * MODW + jsh * DM;
                norm_row(xrow, g, shp, shp + DM, H + (size_t)row * LDH, sl ? (const GAS float*)((const GAS bf16*)Y + (size_t)(row - ML) * DM) : nullptr, sgate, sgs, X + (size_t)row * DM, lane);
            }
        }
        END_PH();
        if (IN_PH() && (PH_MASK & 4)) {
            PH_VIEWS(); LI_VIEWS();
            pg8::Gemm g{H, (const GAS bf16*)(wl + (f == 0 ? WL_13A : WL_13B)), LDH};
            pg8::GridOrder S; S.init(ctx_on ? MT / 256 : ML / 256, 2 * DFF / 256, 0, 0, 0, 0, G, bx, 1, 0, DM / 64);
            S.wgm = WGM_UP; pg8::EpiSwiglu E{U, LDU};
            pg8::gemm_phase<pg8::EpiSwiglu, pg8::GridOrder>(lds + RING_OFF, g, S, E);
            if (S.idle_last()) conv_fill(args, ws, lds, MISC, FILL_UP, 0, wave, lane);
        }
        END_PH();
        if (IN_PH() && (PH_MASK & 8)) {
            PH_VIEWS(); LI_VIEWS();
            pg8::Gemm g{U, (const GAS bf16*)(wl + (f == 0 ? WL_2A : WL_2B)), LDU};
            pg8::GridOrder S; if (ctx_on) S.init(ML / 256, DM / 256, 0, MC / 256, DM / 256, ML / 256, G, bx, 1, 0, DFF / 64, 4, DFF / 256); else S.init(ML / 256, DM / 256, 0, 0, 0, 0, G, bx, 1, 0, DFF / 64);
            S.wgm = WGM_DOWN; if (ROT_DOWN) S.set_rot(ROT_DOWN >= 16 ? ((bx & (ROT_DOWN >> 4)) != 0) : (((bx >> 3) & (ROT_DOWN)) == (ROT_DOWN))); pg8::EpiResid E{xinL, xinC, X, modl, (f == 0 ? 2 : 8) * DM, 0.5f, ML, (GAS float*)Y};
            pg8::gemm_phase<pg8::EpiResid, pg8::GridOrder>(lds + RING_OFF, g, S, E);
        }
        END_PH();
        if (li & 1) continue;
        if (IN_PH() && (PH_MASK & 16)) {
            PH_VIEWS(); LI_VIEWS();
            conv_fill(args, ws, lds, MISC, 0, l * CV_L + CV_A + CV_M, wave, lane);
            const GAS float* g = GIN(IN_N2G) + l * DM;
            const GAS float* sgate = modl + (size_t)8 * MODW + 2 * DM;
            for (int row = gw; row < MT; row += NGW) {
                const int r = row < ML ? row >> 11 : 8; const bool sl = row >= ML;
                const GAS float* xrow = (sl && l == 0) ? GIN(IN_CTX) + (size_t)(row - ML) * DM : X + (size_t)row * DM;
                const GAS float* shp = modl + (size_t)r * MODW + 3 * DM;
                norm_row(xrow, g, shp, shp + DM, H + (size_t)row * LDH, sl ? (const GAS float*)((const GAS bf16*)Y + (size_t)(row - ML) * DM) : nullptr, sgate, 0.5f, X + (size_t)row * DM, lane);
            }
        }
        END_PH();
        if (IN_PH() && (PH_MASK & 32)) {
            PH_VIEWS(); LI_VIEWS();
            pg8::Gemm g{H, (const GAS bf16*)(wl + WL_IN), LDH};
            pg8::GridOrder S;
            if (ctx_q) S.init(MT / 256, DIN / 256, 0, 0, 0, 0, G, bx, 1, 0, DM / 64); else S.init(ML / 256, DIN / 256, 0, MC / 256, 4096 / 256, ML / 256, G, bx, 1, 0, DM / 64);
            S.wgm = WGM_IN; pg8::EpiInproj E{P, DIN, ropeC, ropeS, ML};
            pg8::gemm_phase<pg8::EpiInproj, pg8::GridOrder>(lds + RING_OFF, g, S, E);
            if (S.idle_last()) conv_fill(args, ws, lds, MISC, FILL_IN, 0, wave, lane);
        }
        END_PH();
        if (IN_PH() && (PH_MASK & 128)) {
            PH_VIEWS(); LI_VIEWS();
            char* alds = (char*)lds_raw;
            const float lam = miscf[l]; const float lam_init = l == 0 ? 0.2f : (0.8f - 0.6f * 0.7408182206817179f);
            const f32x4 sg = *((const GAS f32x4*)(GIN(IN_SUBG) + l * 256) + lane) * (1.0f - lam_init);
            const int nquad = (ctx_q && G != 256) ? 288 : 256;
            for (int dq = bx; dq < nquad + G; dq += G) {
                int d = dq; if (dq >= nquad) { if (!(ctx_q && G == 256 && ((bx >> 3) & 7) == 0 && dq < nquad + G)) break; d = 256 + (bx & 7) + 8 * (bx >> 6); }
                const bool isc = d >= 256; const int c = d & 255, b = c & 7, qb = (c >> 3) & 7, h = isc ? (c >> 3) : (c >> 6);
                const size_t q0 = isc ? (size_t)(ML + b * 256) : (size_t)(b * 2048 + 256 * qb);
#if ATT_WIDE
#ifndef ATT_WREP
#define ATT_WREP 1
#endif
#pragma unroll 1
                for (int t_ = 0; t_ < 2 * ATT_WREP; ++t_) { const int t = t_ & 1;
                    att::Unit u; u.Q = P + q0 * DIN + QB_OFF + h * 256 + t * 128;
                    if (isc) { u.K0 = P + q0 * DIN + 2048 + h * 256 + t * 128; u.K1 = u.K0; u.n0 = 4; u.NT = 4; }
                    else { u.K0 = P + (size_t)(b * 2048) * DIN + 2048 + h * 256 + t * 128; u.K1 = P + (size_t)(ML + b * 256) * DIN + 2048 + h * 256 + t * 128; u.n0 = 32; u.NT = 36; }
                    u.dv = 1024 - 128 * t; u.O = O + q0 * LDH + h * 512 + t * 256; u.ldo = LDH; u.r0 = 0; u.kr_lo = 0; u.ntl = 0;
                    att::attn_wide_unit(u, alds); }
                __syncthreads();
#else
#pragma unroll 1
                for (int tv = 0; tv < 4; ++tv) { const int t = tv >> 1, vh = tv & 1;
                    att::Unit u; u.Q = P + q0 * DIN + QB_OFF + h * 256 + t * 128;
                    if (isc) { u.K0 = P + q0 * DIN + 2048 + h * 256 + t * 128; u.K1 = u.K0; u.n0 = 4; u.NT = 4; }
                    else { u.K0 = P + (size_t)(b * 2048) * DIN + 2048 + h * 256 + t * 128; u.K1 = P + (size_t)(ML + b * 256) * DIN + 2048 + h * 256 + t * 128; u.n0 = 32; u.NT = 36; }
                    u.dv = 1024 + 128 * (vh - t); u.O = O + q0 * LDH + h * 512 + t * 256 + vh * 128; u.ldo = LDH; u.r0 = 0; u.kr_lo = 0; u.ntl = 0;
                    att::attn_unit<false, 2>(u, alds); }
#endif
                asm volatile("s_waitcnt vmcnt(0)" ::: "memory");
#pragma unroll 1
                for (int i0 = 0; i0 < 32; i0 += 16) {
                    v2u a[16], bq[16];
#pragma unroll
                    for (int i = 0; i < 16; ++i) { const size_t row = q0 + wave * 32 + i0 + i; a[i] = __builtin_nontemporal_load((const GAS v2u*)(O + row * LDH + h * 512) + lane); bq[i] = __builtin_nontemporal_load((const GAS v2u*)(O + row * LDH + h * 512 + 256) + lane); }
                    f32x4 dd[16]; float ssq[16];
#pragma unroll
                    for (int i = 0; i < 16; ++i) { dd[i].x = pg8::bf_lo(a[i].x) - lam * pg8::bf_lo(bq[i].x); dd[i].y = pg8::bf_hi(a[i].x) - lam * pg8::bf_hi(bq[i].x); dd[i].z = pg8::bf_lo(a[i].y) - lam * pg8::bf_lo(bq[i].y); dd[i].w = pg8::bf_hi(a[i].y) - lam * pg8::bf_hi(bq[i].y);
                        ssq[i] = (dd[i].x * dd[i].x + dd[i].y * dd[i].y) + (dd[i].z * dd[i].z + dd[i].w * dd[i].w); }
#pragma unroll
                    for (int o = 1; o < 64; o <<= 1)
#pragma unroll
                        for (int i = 0; i < 16; ++i) ssq[i] += __shfl_xor(ssq[i], o);
#pragma unroll
                    for (int i = 0; i < 16; ++i) { const size_t row = q0 + wave * 32 + i0 + i; const float rstd = 1.0f / sqrtf(ssq[i] * (1.0f / 256.0f) + EPS);
                        const f32x4 y = dd[i] * rstd * sg; v2u w; w.x = pk2(y.x, y.y); w.y = pk2(y.z, y.w);
                        *((GAS v2u*)(Y + row * LDH + 1024 + h * 256) + lane) = w; }
                }
            }
            if (ctx_q) for (int s0 = (G == 256 ? 0 : bx); s0 < (G == 256 ? ((((bx >> 3) & 7) == 7) ? 2 : 0) : 64); s0 += (G == 256 ? 1 : G)) {
                att::Unit u; u.n0 = 4; u.NT = 4; u.ldo = LDH; u.r0 = 0; u.kr_lo = 0; u.ntl = 0;
                const int s = G == 256 ? (bx & 7) + 8 * ((bx >> 6) + 4 * s0) : s0; const int b = s & 7, h = s >> 3; const size_t r0 = (size_t)(ML + b * 256);
                u.Q = P + r0 * DIN + QA_OFF + h * 128; u.K0 = P + r0 * DIN + h * 128; u.K1 = u.K0; u.dv = 1024; u.O = Y + r0 * LDH + h * 128;
                if (ATT_DMA) att::attn_dma_unit<false>(u, alds); else att::attn_unit<false, 2>(u, alds);
            }
#ifndef NA_REP
#define NA_REP 1
#endif
            if (PH_MASK & 0x40000) for (int nrep_ = 0; nrep_ < NA_REP; ++nrep_) for (int n = bx; n < 512; n += G) {
                const int k = n >> 8, c = n & 255, b = c & 7, rg = (c >> 3) & 7, h = 4 * k + (c >> 6);
                const int r0 = 4 * rg, kr_lo = r0 - 4 < 0 ? 0 : r0 - 4, kr_hi = (r0 - 1 < 0 ? 0 : (r0 - 1 > 24 ? 24 : r0 - 1)) + 7, ntl = kr_hi - kr_lo + 1;
                { float* tbl = (float*)(alds + (ATT_DMA ? att::D_TBL : att::TBL_OFF)); const GAS float* rp = GIN(IN_RPB) + ((size_t)l * 8 + h) * 15 * 31;
                  for (int i = tid; i < 15 * 128; i += NWAVES * 64) { const int dr = i >> 7, dc = (i & 127) - 48; tbl[i] = (dc >= 0 && dc <= 30) ? rp[dr * 31 + dc] * 11.313708498984761f : 0.f; } }
                att::Unit u; u.Q = P + (size_t)(b * 2048 + 256 * rg) * DIN + QA_OFF + h * 128;
                u.K0 = P + (size_t)(ML + b * 256) * DIN + h * 128; u.K1 = P + (size_t)(b * 2048 + 64 * kr_lo) * DIN + h * 128; u.n0 = 4; u.dv = 1024; u.NT = (4 + ntl + 1) & ~1;
                u.O = Y + (size_t)(b * 2048 + 256 * rg) * LDH + h * 128; u.ldo = LDH; u.r0 = r0; u.kr_lo = kr_lo; u.ntl = ntl;
                if (ATT_DMA) { __syncthreads(); att::attn_dma_unit<true>(u, alds); } else att::attn_unit<true, NA_SD>(u, alds);
            }
        }
        END_PH();
        if (IN_PH() && (PH_MASK & 512)) {
            PH_VIEWS(); LI_VIEWS();
            pg8::Gemm g{Y, (const GAS bf16*)(wl + WL_PAB), LDH};
            pg8::GridOrder S; S.init(ctx_q ? MT / 256 : ML / 256, DM / 256, 0, 0, 0, 0, G, bx, 2, 1024, 1024 / 64);
            S.wgm = WGM_M1; pg8::EpiMerge1 E{P + G_OFF, DIN, Z, LDH};
            pg8::gemm_phase<pg8::EpiMerge1, pg8::GridOrder>(lds + RING_OFF, g, S, E);
            if (S.idle_last()) conv_fill(args, ws, lds, MISC, FILL_M1, 0, wave, lane);
        }
        END_PH();
        if (IN_PH() && (PH_MASK & 1024)) {
            PH_VIEWS(); LI_VIEWS();
            pg8::Gemm g{Z, (const GAS bf16*)(wl + WL_O), LDH};
            pg8::GridOrder S; if (ctx_q) S.init(ML / 256, DM / 256, 0, MC / 256, DM / 256, ML / 256, G, bx, 1, 0, DM / 64, 4, DM / 256); else S.init(ML / 256, DM / 256, 0, 0, 0, 0, G, bx, 1, 0, DM / 64);
            S.wgm = WGM_M2; pg8::EpiResid E{X, X + (size_t)ML * DM, X, modl, 5 * DM, 1.0f, ML, (GAS float*)Y};
            pg8::gemm_phase<pg8::EpiResid, pg8::GridOrder>(lds + RING_OFF, g, S, E);
        }
        END_PH();
    }
    if (IN_PH() && (PH_MASK & 2048)) {
        PH_VIEWS();
        const GAS float* g = GIN(IN_FG);
        for (int row = gw; row < ML; row += NGW) {
            const GAS f32x4* xr = (const GAS f32x4*)(X + (size_t)row * DM) + lane;
            f32x4 v[8], g8[8]; float ss = 0.f; const GAS f32x4* gp = (const GAS f32x4*)g + lane;
#pragma unroll
            for (int j = 0; j < 8; ++j) v[j] = xr[64 * j];
#pragma unroll
            for (int j = 0; j < 8; ++j) g8[j] = gp[64 * j];
#pragma unroll
            for (int j = 0; j < 8; ++j) ss += (v[j].x * v[j].x + v[j].y * v[j].y) + (v[j].z * v[j].z + v[j].w * v[j].w);
            const float rstd = 1.0f / sqrtf(wave_sum(ss) * (1.0f / DM) + EPS);
            GAS f32x4* op = (GAS f32x4*)((GAS float*)args.out + (size_t)row * DM) + lane;
#pragma unroll
            for (int j = 0; j < 8; ++j) op[64 * j] = v[j] * rstd * g8[j];
        }
    }
    END_PH();
#undef IN_PH
#undef END_PH
}
extern "C" void kernel_launch(void* const* d_in, const int* in_sizes, int n_in, void* d_out, int out_size, void* d_ws, size_t ws_size, hipStream_t stream) {
    static int grid = 0;
    if (grid == 0) {
        if (n_in != N_IN || in_sizes[0] != ML * DM || out_size != ML * DM || ws_size < WS_END) { fprintf(stderr, "kernel_launch: shape mismatch (n_in %d, in0 %d, out %d, ws %zu < %zu); nothing launched\n", n_in, n_in > 0 ? in_sizes[0] : -1, out_size, ws_size, (size_t)WS_END); grid = -1; return; }
        int dev = 0, cus = 0, per_cu = 0;
        if (hipGetDevice(&dev) != hipSuccess || hipDeviceGetAttribute(&cus, hipDeviceAttributeMultiprocessorCount, dev) != hipSuccess) { fprintf(stderr, "kernel_launch: device query failed\n"); grid = -1; return; }
        if (hipFuncSetAttribute((const void*)mega_fwd, hipFuncAttributeMaxDynamicSharedMemorySize, LDS_BYTES) != hipSuccess) { fprintf(stderr, "kernel_launch: hipFuncSetAttribute failed\n"); grid = -1; return; }
        if (hipOccupancyMaxActiveBlocksPerMultiprocessor(&per_cu, (const void*)mega_fwd, NWAVES * 64, LDS_BYTES) != hipSuccess || per_cu < 1)
            fprintf(stderr, "kernel_launch: note: occupancy query reports %d workgroups per CU\n", per_cu);
        (void)hipGetLastError();
        grid = cus;
    }
    if (grid < 0) return;
    if (hipMemsetAsync((char*)d_ws + WS_CTL, 0, CTL_ZERO_BYTES, stream) != hipSuccess) { fprintf(stderr, "kernel_launch: memset failed\n"); return; }
    Args a{};
    for (int i = 0; i < N_IN; ++i) a.in[i] = (const float*)d_in[i];
    a.out = (float*)d_out; a.ws = (unsigned char*)d_ws;
#ifdef DBG_CHECK
    dbg_run(a, grid, stream);
#else
#ifndef MK_PER_PHASE
    a.ph_lo = 0; a.ph_hi = N_PHASES;
    hipLaunchKernelGGL(mega_fwd, dim3(grid), dim3(NWAVES * 64), LDS_BYTES, stream, a);
#else
    for (int p = 0; p < N_PHASES; ++p) { a.ph_lo = p; a.ph_hi = p + 1; hipLaunchKernelGGL(mega_fwd, dim3(grid), dim3(NWAVES * 64), LDS_BYTES, stream, a); }
#endif
    const hipError_t le = hipPeekAtLastError();
    if (le != hipSuccess) fprintf(stderr, "kernel_launch: launch failed: %s\n", hipGetErrorName(le));
#endif
}
```

```cpp
#include <hip/hip_runtime.h>
#include <cstdio>
#include <cstdint>
namespace pg8 {
#define PG8_LAS __attribute__((address_space(3)))
#define PG8_GAS __attribute__((address_space(1)))
typedef unsigned short bf16_t;
typedef short bf16x8 __attribute__((ext_vector_type(8)));
typedef float f32x4 __attribute__((ext_vector_type(4)));
typedef unsigned u32x4 __attribute__((ext_vector_type(4)));
constexpr int BM = 256, BK = 64, HALF = 128, HTB = HALF * BK * 2  , STAGE_BYTES = 8 * HTB, NXCD = 8;
#ifndef PG8_WGM
#define PG8_WGM 4
#endif
constexpr int WGM = PG8_WGM;

__host__ __device__ __forceinline__ int lds_byte(int r, int c) { const int st = (r >> 4) * 2 + (c >> 5), rr = r & 15, cc = c & 31, ob = rr * 64 + cc * 2; return st * 1024 + (ob ^ (((ob >> 9) & 1) << 5)); }
__host__ __device__ __forceinline__ void stage_rc(int b, int& R, int& C) { const int st = b / 1024, sb = b % 1024, swz = sb ^ (((sb >> 9) & 1) << 5); R = (st >> 1) * 16 + swz / 64; C = (st & 1) * 32 + (swz % 64) / 2; }
__host__ __device__ __forceinline__ int perm32(int rho) { const int n = rho >> 4, i = rho & 15; return 8 * (i >> 2) + 4 * n + (i & 3); }

struct Unit { int pm, pn, koff, flags, nt; };
struct Gemm { const PG8_GAS bf16_t* A; const PG8_GAS bf16_t* Bt; int ld; };

struct GridOrder {
    int nM, nN, nwg, pm0, nM2, nN2, nwg2, pm02, G, c, passes, kpass, nt1, ks2, nt2, wgm, rot = 0, nrc = 0;
    __device__ __forceinline__ void init(int nM_, int nN_, int pm0_, int nM2_, int nN2_, int pm02_, int G_, int c_, int passes_, int kpass_, int nt1_, int ks2_ = 1, int nt2_ = 0) {
        nM = nM_; nN = nN_; nwg = nM_ * nN_; pm0 = pm0_; nM2 = nM2_; nN2 = nN2_; nwg2 = nM2_ * nN2_ * ks2_; pm02 = pm02_; G = G_; c = c_; passes = passes_; kpass = kpass_; nt1 = nt1_; ks2 = ks2_; nt2 = ks2_ == 1 ? nt1_ : nt2_; wgm = WGM; }
    __device__ __forceinline__ void decode(int wgid, int nM_, int nN_, int nwg_, int& pm, int& pn) const {
        { const int q = nwg_ / NXCD, r = nwg_ % NXCD, xcd = wgid % NXCD, off = wgid / NXCD; wgid = (xcd < r ? xcd * (q + 1) : r * (q + 1) + (xcd - r) * q) + off; }
        const int nig = wgm * nN_, gid = wgid / nig, fm = gid * wgm, gsz = (nM_ - fm) < wgm ? (nM_ - fm) : wgm;
        pm = fm + ((wgid % nig) % gsz); pn = (wgid % nig) / gsz; }
    __device__ __forceinline__ void set_rot(bool on) { const int total = nwg + nwg2; nrc = c < total ? (total - c + G - 1) / G : 0; rot = (on && nrc > 1) ? 1 : 0; }
    __device__ __forceinline__ bool idle_last() const { const int total = nwg + nwg2; if (total % G == 0) return false; return (long)(total / G) * G + c >= total; }
    __device__ __forceinline__ bool next(int i, Unit& u) const {
        int ti = passes == 2 ? (i >> 1) : i; const int ps = passes == 2 ? (i & 1) : 0;
        if (rot) { if (ti >= nrc) return false; ti += nrc - 1; if (ti >= nrc) ti -= nrc; }
        const long L = (long)ti * G + c;
        if (L < nwg) { decode((int)L, nM, nN, nwg, u.pm, u.pn); u.pm += pm0; u.koff = ps * kpass; u.flags = (ps == 0 ? 1 : 0) | (ps == passes - 1 ? 2 : 0); u.nt = nt1; }
        else if (L - nwg < nwg2) { const int L2 = (int)(L - nwg), q = L2 % ks2; decode(L2 / ks2, nM2, nN2, nwg2 / ks2, u.pm, u.pn); u.pm += pm02;
            if (ks2 == 1) { u.koff = ps * kpass; u.flags = (ps == 0 ? 1 : 0) | (ps == passes - 1 ? 2 : 0); } else { u.koff = q * nt2 * BK; u.flags = 3 | 4 | (q << 4); }
            u.nt = nt2; }
        else return false;
        return true; }
};

__device__ __forceinline__ unsigned cvt_pk_bf16(float lo, float hi) { unsigned r; asm volatile("v_cvt_pk_bf16_f32 %0, %1, %2" : "=v"(r) : "v"(lo), "v"(hi)); return r; }

template <class Epi, class Sched>
__device__ __forceinline__ void gemm_phase(PG8_LAS unsigned char* lds, const Gemm g, const Sched& S, const Epi& E) {
    int tid_ = threadIdx.x; asm volatile("" : "+v"(tid_));
    const int tid = tid_, wid = __builtin_amdgcn_readfirstlane(tid >> 6), lane = tid & 63, wr = wid >> 2, wc = wid & 3, fr = lane & 15, fq = lane >> 4;
    const int ld = g.ld;
    unsigned voffA[2], voffB[2];
#pragma unroll
    for (int i = 0; i < 2; ++i) { int R, C; stage_rc(tid * 16 + i * 8192, R, C); const int Rb = Epi::PERM ? ((R & ~31) + perm32(R & 31)) : R;
        voffA[i] = (unsigned)(R * ld + C) * 2u; voffB[i] = (unsigned)(Rb * ld + C) * 2u; }
    const size_t kstep = (size_t)(BK * 2);
    const size_t hstep = (size_t)HALF * ld * 2;
    const size_t tstep = 2 * hstep;
    const unsigned ldsw = (unsigned)wid * 1024u;
    const int aoff = lds_byte(wr * 64 + fr, fq * 8), boff = lds_byte(wc * 32 + fr, fq * 8);
#define PG8_SA(b, h) (((b) * 2 + (h)) * HTB)
#define PG8_SB(b, h) ((4 + (b) * 2 + (h)) * HTB)
#ifndef PG8_SP2
#define PG8_SP2 1
#endif
#ifndef PG8_SERP
#define PG8_SERP 0
#endif
#ifndef PG8_AUX_A
#define PG8_AUX_A 0
#endif
#ifndef PG8_AUX_B
#define PG8_AUX_B 0
#endif
#define PG8_STAGE_X(bufoff, gbase, voff, aux) do { _Pragma("unroll") for (int _i = 0; _i < 2; ++_i) \
        __builtin_amdgcn_global_load_lds((const PG8_GAS unsigned*)((gbase) + (voff)[_i]), (PG8_LAS unsigned*)(lds + (bufoff) + ldsw + _i * 8192), 16, 0, aux); } while (0)
#define PG8_STAGE(bufoff, gbase, voff) do { if ((bufoff) >= 4 * HTB) PG8_STAGE_X(bufoff, gbase, voff, PG8_AUX_B); else PG8_STAGE_X(bufoff, gbase, voff, PG8_AUX_A); } while (0)
#define PG8_LDA(dst, b, h) do { _Pragma("unroll") for (int m = 0; m < 4; ++m) _Pragma("unroll") for (int k = 0; k < 2; ++k) dst[m][k] = *(const PG8_LAS bf16x8*)(lds + PG8_SA(b, h) + aoff + m * 2048 + k * 1024); } while (0)
#define PG8_LDB(dst, b, h) do { _Pragma("unroll") for (int n = 0; n < 2; ++n) _Pragma("unroll") for (int k = 0; k < 2; ++k) dst[n][k] = *(const PG8_LAS bf16x8*)(lds + PG8_SB(b, h) + boff + n * 2048 + k * 1024); } while (0)
#ifndef PG8_PRIO
#define PG8_PRIO 0
#endif
#define PG8_MMA(ai, bj, At, Bt) do { if (PG8_PRIO == 0) __builtin_amdgcn_s_setprio(1); _Pragma("unroll") for (int m = 0; m < 4; ++m) _Pragma("unroll") for (int n = 0; n < 2; ++n) _Pragma("unroll") for (int k = 0; k < 2; ++k) \
        acc[ai][bj][m][n] = __builtin_amdgcn_mfma_f32_16x16x32_bf16(Bt[n][k], At[m][k], acc[ai][bj][m][n], 0, 0, 0); if (PG8_PRIO == 0) __builtin_amdgcn_s_setprio(0); } while (0)
#define PG8_WAIT_V(n) asm volatile("s_waitcnt vmcnt(" #n ")" ::: "memory")
#define PG8_WAIT_L(n) asm volatile("s_waitcnt lgkmcnt(" #n ")" ::: "memory")
#define PG8_BAR __builtin_amdgcn_s_barrier()
#define PG8_SCHED __builtin_amdgcn_sched_barrier(0)
    Unit cur, nxt; int ui = 0;
    if (!S.next(0, cur)) return;
    if (PG8_PRIO == 1 && wr == 1) __builtin_amdgcn_s_setprio(1);
    f32x4 acc[2][2][4][2];
#pragma unroll
    for (int a = 0; a < 2; ++a)
#pragma unroll
        for (int b = 0; b < 2; ++b)
#pragma unroll
            for (int m = 0; m < 4; ++m)
#pragma unroll
                for (int n = 0; n < 2; ++n) acc[a][b][m][n] = (f32x4){0.f, 0.f, 0.f, 0.f};
    bf16x8 At[4][2], B0[2][2], B1[2][2];
    long kd = (long)kstep;
    const PG8_GAS char* cA = (const PG8_GAS char*)g.A + (size_t)cur.pm * tstep + (size_t)cur.koff * 2; const PG8_GAS char* cB = (const PG8_GAS char*)g.Bt + (size_t)cur.pn * tstep + (size_t)cur.koff * 2;
#if PG8_SP2
    PG8_STAGE(PG8_SB(0, 0), cB, voffB); PG8_STAGE(PG8_SB(0, 1), cB + hstep, voffB); PG8_STAGE(PG8_SA(0, 0), cA, voffA); PG8_STAGE(PG8_SA(0, 1), cA + hstep, voffA);
    if (wr == 1) PG8_BAR;
    PG8_WAIT_V(2); PG8_BAR;
    PG8_STAGE(PG8_SB(1, 0), cB + kd, voffB); PG8_STAGE(PG8_SA(1, 0), cA + kd, voffA); PG8_STAGE(PG8_SB(1, 1), cB + hstep + kd, voffB);
    PG8_WAIT_V(6); PG8_BAR;
#else
    PG8_STAGE(PG8_SB(0, 0), cB, voffB); PG8_STAGE(PG8_SA(0, 0), cA, voffA); PG8_STAGE(PG8_SB(0, 1), cB + hstep, voffB); PG8_STAGE(PG8_SA(0, 1), cA + hstep, voffA);
    if (wr == 1) PG8_BAR;
    PG8_WAIT_V(4); PG8_BAR;
    PG8_STAGE(PG8_SB(1, 0), cB + kd, voffB); PG8_STAGE(PG8_SA(1, 0), cA + kd, voffA); PG8_STAGE(PG8_SB(1, 1), cB + hstep + kd, voffB);
    PG8_WAIT_V(6); PG8_BAR;
#endif
    for (;;) {
        const bool has_next = S.next(ui + 1, nxt);
        const bool nrev = PG8_SERP && has_next && ((ui + 1) & 1);
        const long nkd = has_next ? (nrev ? -(long)kstep : (long)kstep) : kd; const size_t nst = nrev ? (size_t)(nxt.nt - 1) * kstep : 0;
        const PG8_GAS char* nA = has_next ? (const PG8_GAS char*)g.A + (size_t)nxt.pm * tstep + (size_t)nxt.koff * 2 + nst : cA; const PG8_GAS char* nB = has_next ? (const PG8_GAS char*)g.Bt + (size_t)nxt.pn * tstep + (size_t)nxt.koff * 2 + nst : cB;
        const int nt = cur.nt;
        for (int t = 0; t < nt; t += 2) {
            if constexpr (Epi::PF) { if (t == nt - 4) E.prefetch(cur, tid, lds + STAGE_BYTES + wid * 256); }
            const bool last = (t == nt - 2);
            const PG8_GAS char* a1 = cA + (long)(t + 1) * kd;
            const PG8_GAS char* a2 = last ? nA : cA + (long)(t + 2) * kd; const PG8_GAS char* b2 = last ? nB : cB + (long)(t + 2) * kd;
            const long kd3 = last ? nkd : kd; const PG8_GAS char* a3 = a2 + kd3; const PG8_GAS char* b3 = b2 + kd3;
#if PG8_SP2
            PG8_LDB(B0, 0, 0); PG8_LDB(B1, 0, 1); PG8_SCHED; PG8_LDA(At, 0, 0); PG8_STAGE(PG8_SA(1, 1), a1 + hstep, voffA);
            PG8_WAIT_V(8); PG8_WAIT_L(0); PG8_BAR; PG8_MMA(0, 0, At, B0); PG8_MMA(0, 1, At, B1); PG8_BAR; PG8_SCHED;
            PG8_LDA(At, 0, 1); PG8_STAGE(PG8_SB(0, 0), b2, voffB); PG8_STAGE(PG8_SB(0, 1), b2 + hstep, voffB); PG8_STAGE(PG8_SA(0, 0), a2, voffA);
            PG8_WAIT_V(8); PG8_WAIT_L(0); PG8_BAR; PG8_MMA(1, 0, At, B0); PG8_MMA(1, 1, At, B1); PG8_BAR; PG8_SCHED;
            PG8_LDB(B0, 1, 0); PG8_LDB(B1, 1, 1); PG8_SCHED; PG8_LDA(At, 1, 0); PG8_STAGE(PG8_SA(0, 1), a2 + hstep, voffA);
            PG8_WAIT_V(8); PG8_WAIT_L(0); PG8_BAR; PG8_MMA(0, 0, At, B0); PG8_MMA(0, 1, At, B1); PG8_BAR; PG8_SCHED;
            PG8_LDA(At, 1, 1); PG8_STAGE(PG8_SB(1, 0), b3, voffB); PG8_STAGE(PG8_SB(1, 1), b3 + hstep, voffB); PG8_STAGE(PG8_SA(1, 0), a3, voffA);
            PG8_WAIT_V(8); PG8_WAIT_L(0); PG8_BAR; PG8_MMA(1, 0, At, B0); PG8_MMA(1, 1, At, B1); PG8_BAR; PG8_SCHED;
#else
            PG8_LDB(B0, 0, 0); PG8_SCHED; PG8_LDA(At, 0, 0); PG8_STAGE(PG8_SA(1, 1), a1 + hstep, voffA);
            PG8_WAIT_L(8); PG8_BAR; PG8_WAIT_L(0); PG8_MMA(0, 0, At, B0); PG8_BAR; PG8_SCHED;
            PG8_LDB(B1, 0, 1); PG8_STAGE(PG8_SB(0, 0), b2, voffB);
            PG8_BAR; PG8_WAIT_L(0); PG8_MMA(0, 1, At, B1); PG8_BAR;
            PG8_LDA(At, 0, 1); PG8_STAGE(PG8_SA(0, 0), a2, voffA);
            PG8_BAR; PG8_WAIT_L(0); PG8_MMA(1, 0, At, B0); PG8_BAR; PG8_SCHED;
            PG8_STAGE(PG8_SB(0, 1), b2 + hstep, voffB);
            PG8_WAIT_V(6); PG8_BAR; PG8_MMA(1, 1, At, B1); PG8_BAR;
            PG8_LDB(B0, 1, 0); PG8_SCHED; PG8_LDA(At, 1, 0); PG8_STAGE(PG8_SA(0, 1), a2 + hstep, voffA);
            PG8_WAIT_L(8); PG8_BAR; PG8_WAIT_L(0); PG8_MMA(0, 0, At, B0); PG8_BAR; PG8_SCHED;
            PG8_LDB(B1, 1, 1); PG8_STAGE(PG8_SB(1, 0), b3, voffB);
            PG8_BAR; PG8_WAIT_L(0); PG8_MMA(0, 1, At, B1); PG8_BAR;
            PG8_LDA(At, 1, 1); PG8_STAGE(PG8_SA(1, 0), a3, voffA);
            PG8_BAR; PG8_WAIT_L(0); PG8_MMA(1, 0, At, B0); PG8_BAR; PG8_SCHED;
            PG8_STAGE(PG8_SB(1, 1), b3 + hstep, voffB);
            PG8_WAIT_V(6); PG8_BAR; PG8_MMA(1, 1, At, B1); PG8_BAR;
#endif
        }
        if (wr == 0) PG8_BAR;
        E(acc, cur, wr, wc, fr, fq);
        if (!has_next) break;
        if (nxt.flags & 1) {
#pragma unroll
        for (int a = 0; a < 2; ++a)
#pragma unroll
            for (int b = 0; b < 2; ++b)
#pragma unroll
                for (int m = 0; m < 4; ++m)
#pragma unroll
                    for (int n = 0; n < 2; ++n) acc[a][b][m][n] = (f32x4){0.f, 0.f, 0.f, 0.f};
        }
        cur = nxt; cA = nA; cB = nB; kd = nkd; ++ui;
        if (wr == 1) PG8_BAR;
    }
    if (PG8_PRIO == 1) __builtin_amdgcn_s_setprio(0);
    PG8_WAIT_V(0);
    PG8_BAR;
#undef PG8_SA
#undef PG8_SB
#undef PG8_STAGE
#undef PG8_STAGE_X
#undef PG8_LDA
#undef PG8_LDB
#undef PG8_MMA
#undef PG8_WAIT_V
#undef PG8_WAIT_L
#undef PG8_BAR
#undef PG8_SCHED
}
}
namespace pg8 {
typedef PG8_GAS bf16_t gbf; typedef PG8_GAS float gfl; typedef PG8_GAS f32x4 gf4; typedef PG8_GAS u32x4 gu4;
#ifndef WT_STORES
#define WT_STORES 0
#endif
#ifndef NT_EPI
#define NT_EPI 0
#endif
__device__ __forceinline__ void st16(gu4* p, u32x4 v) {
#if WT_STORES
    asm volatile("global_store_dwordx4 %0, %1, off sc1" :: "v"(p), "v"(v) : "memory");
#elif NT_EPI
    __builtin_nontemporal_store(v, p);
#else
    *p = v;
#endif
}
__device__ __forceinline__ void st16f(gf4* p, f32x4 v) {
#if WT_STORES
    asm volatile("global_store_dwordx4 %0, %1, off sc1" :: "v"(p), "v"(v) : "memory");
#elif NT_EPI
    __builtin_nontemporal_store(v, p);
#else
    *p = v;
#endif
}
#ifndef RESID_BATCH
#define RESID_BATCH 4
#endif
#ifndef NT_P
#define NT_P 0
#endif
__device__ __forceinline__ void st16p(gu4* p, u32x4 v) {
#if NT_P
    __builtin_nontemporal_store(v, p);
#else
    *p = v;
#endif
}
__device__ __forceinline__ f32x4 ld16f(const gf4* p) {
#if NT_EPI
    return __builtin_nontemporal_load(p);
#else
    return *p;
#endif
}
__device__ __forceinline__ float fast_sigmoid(float x) { return __builtin_amdgcn_rcpf(1.0f + __builtin_amdgcn_exp2f(-1.4426950408889634f * x)); }
__device__ __forceinline__ float bf_lo(unsigned w) { return __uint_as_float(w << 16); }
__device__ __forceinline__ float bf_hi(unsigned w) { return __uint_as_float(w & 0xffff0000u); }

struct EpiBf16 {
    static constexpr bool PERM = true; static constexpr int IDEMP = 1; static constexpr bool PF = false;
    gbf* O; int ldc;
    __device__ __forceinline__ void operator()(f32x4 (&acc)[2][2][4][2], const Unit& u, int wr, int wc, int fr, int fq) const {
        const int row0 = u.pm * BM + wr * 64 + fr, col0 = u.pn * BM + wc * 32 + 8 * fq;
#pragma unroll
        for (int ai = 0; ai < 2; ++ai)
#pragma unroll
            for (int m = 0; m < 4; ++m) { gbf* rowp = O + (size_t)(row0 + ai * HALF + m * 16) * ldc + col0;
#pragma unroll
                for (int bj = 0; bj < 2; ++bj) { const f32x4 v0 = acc[ai][bj][m][0], v1 = acc[ai][bj][m][1];
                    u32x4 w; w.x = cvt_pk_bf16(v0[0], v0[1]); w.y = cvt_pk_bf16(v0[2], v0[3]); w.z = cvt_pk_bf16(v1[0], v1[1]); w.w = cvt_pk_bf16(v1[2], v1[3]);
                    st16((gu4*)(rowp + bj * HALF), w); } }
    }
};

struct EpiInproj {
    static constexpr bool PERM = true; static constexpr int IDEMP = 1; static constexpr bool PF = false;
    gbf* O; int ldc; const gfl* ropeC; const gfl* ropeS; int MLr;
    __device__ __forceinline__ void operator()(f32x4 (&acc)[2][2][4][2], const Unit& u, int wr, int wc, int fr, int fq) const {
        const int row0 = u.pm * BM + wr * 64 + fr, col0 = u.pn * BM + wc * 32 + 8 * fq;
        const bool rot = ((u.pn >= 8 && u.pn < 12) || (u.pn >= 20 && u.pn < 24)) && (u.pm * BM) < MLr;
        const int toff = (wc >> 1) * 32 + 16 * (wc & 1) + 4 * fq;
        if (rot) {
#pragma unroll
            for (int ai = 0; ai < 2; ++ai) {
                f32x4 cs[4], sn[4];
#pragma unroll
                for (int m = 0; m < 4; ++m) { const int t = (row0 + ai * HALF + m * 16) & 2047; cs[m] = *(const gf4*)(ropeC + t * 64 + toff); sn[m] = *(const gf4*)(ropeS + t * 64 + toff); }
#pragma unroll
                for (int m = 0; m < 4; ++m) { gbf* rowp = O + (size_t)(row0 + ai * HALF + m * 16) * ldc + col0;
#pragma unroll
                    for (int bj = 0; bj < 2; ++bj) { const f32x4 x0 = acc[ai][bj][m][0], x1 = acc[ai][bj][m][1];
                        const f32x4 v0 = x0 * cs[m] - x1 * sn[m], v1 = x0 * sn[m] + x1 * cs[m];
                        u32x4 w; w.x = cvt_pk_bf16(v0[0], v0[1]); w.y = cvt_pk_bf16(v0[2], v0[3]); w.z = cvt_pk_bf16(v1[0], v1[1]); w.w = cvt_pk_bf16(v1[2], v1[3]);
                        st16p((gu4*)(rowp + bj * HALF), w); } } }
        } else {
#pragma unroll
            for (int ai = 0; ai < 2; ++ai)
#pragma unroll
                for (int m = 0; m < 4; ++m) { gbf* rowp = O + (size_t)(row0 + ai * HALF + m * 16) * ldc + col0;
#pragma unroll
                    for (int bj = 0; bj < 2; ++bj) { const f32x4 v0 = acc[ai][bj][m][0], v1 = acc[ai][bj][m][1];
                        u32x4 w; w.x = cvt_pk_bf16(v0[0], v0[1]); w.y = cvt_pk_bf16(v0[2], v0[3]); w.z = cvt_pk_bf16(v1[0], v1[1]); w.w = cvt_pk_bf16(v1[2], v1[3]);
                        st16p((gu4*)(rowp + bj * HALF), w); } }
        }
    }
};

struct EpiSwiglu {
    static constexpr bool PERM = false; static constexpr int IDEMP = 2; static constexpr bool PF = false;
    gbf* U; int ldc;
    __device__ __forceinline__ void operator()(f32x4 (&acc)[2][2][4][2], const Unit& u, int wr, int wc, int fr, int fq) const {
        const int row0 = u.pm * BM + wr * 64 + fr, col0 = u.pn * HALF + wc * 32 + 8 * fq;
#pragma unroll
        for (int ai = 0; ai < 2; ++ai)
#pragma unroll
            for (int m = 0; m < 4; ++m) { gbf* rowp = U + (size_t)(row0 + ai * HALF + m * 16) * ldc + col0;
                f32x4 h[2];
#pragma unroll
                for (int bj = 0; bj < 2; ++bj) { const f32x4 gt = acc[ai][bj][m][0], up = acc[ai][bj][m][1];
#pragma unroll
                    for (int e = 0; e < 4; ++e) h[bj][e] = gt[e] * fast_sigmoid(gt[e]) * up[e]; }
                u32x4 w; w.x = cvt_pk_bf16(h[0][0], h[0][1]); w.y = cvt_pk_bf16(h[0][2], h[0][3]); w.z = cvt_pk_bf16(h[1][0], h[1][1]); w.w = cvt_pk_bf16(h[1][2], h[1][3]);
                st16((gu4*)rowp, w); }
    }
};

struct EpiResid {
    static constexpr bool PERM = false; static constexpr int IDEMP = 0;
#ifndef RESID_PF
#define RESID_PF 0
#endif
    static constexpr bool PF = RESID_PF != 0;
    __device__ __forceinline__ void prefetch(const Unit& u, int tid, PG8_LAS unsigned char* dummy) const {
        if (u.flags & 4) return;
        const bool isL = (u.pm * BM) < MLr;
        const gfl* bp = isL ? baseL + (size_t)(u.pm * BM) * 2048 : baseC + (size_t)(u.pm * BM - MLr) * 2048;
#pragma unroll
        for (int i = 0; i < 4; ++i) { const int idx = i * 512 + tid, row = idx >> 3, seg = idx & 7;
            __builtin_amdgcn_global_load_lds((const PG8_GAS unsigned*)(bp + (size_t)row * 2048 + u.pn * BM + seg * 32), (PG8_LAS unsigned*)dummy, 4, 0, 0); }
    }
    const gfl* baseL; const gfl* baseC; gfl* out; const gfl* modl; int gate_off; float gs; int MLr; gfl* slab;
    __device__ __forceinline__ void operator()(f32x4 (&acc)[2][2][4][2], const Unit& u, int wr, int wc, int fr, int fq) const {
        const int row0 = u.pm * BM + wr * 64 + fr, col0 = u.pn * BM + wc * 32 + 4 * fq;
        if (u.flags & 4) {
            gbf* sp = (gbf*)slab + ((size_t)((u.flags >> 4) & 3) * 2048 + (size_t)(row0 - MLr)) * 2048 + col0;
#pragma unroll
            for (int ai = 0; ai < 2; ++ai)
#pragma unroll
                for (int m = 0; m < 4; ++m) { const size_t ro = (size_t)(ai * HALF + m * 16) * 2048;
#pragma unroll
                    for (int bj = 0; bj < 2; ++bj)
#pragma unroll
                        for (int n = 0; n < 2; ++n) { const f32x4 v = acc[ai][bj][m][n]; typedef unsigned u32x2 __attribute__((ext_vector_type(2)));
                            u32x2 w; w.x = cvt_pk_bf16(v[0], v[1]); w.y = cvt_pk_bf16(v[2], v[3]); *(PG8_GAS u32x2*)(sp + ro + bj * HALF + n * 16) = w; } }
            return; }
        const bool isL = (u.pm * BM) < MLr;
        const int r = isL ? (u.pm * BM) >> 11 : 8;
        const gfl* gp = modl + (size_t)r * 18432 + gate_off + col0;
        const gfl* bp = isL ? baseL + (size_t)row0 * 2048 + col0 : baseC + (size_t)(row0 - MLr) * 2048 + col0;
        gfl* op = out + (size_t)row0 * 2048 + col0;
        f32x4 gv[2][2];
#pragma unroll
        for (int bj = 0; bj < 2; ++bj)
#pragma unroll
            for (int n = 0; n < 2; ++n) gv[bj][n] = *(const gf4*)(gp + bj * HALF + n * 16) * gs;
#pragma unroll
        for (int ai = 0; ai < 2; ++ai)
#pragma unroll
            for (int mh = 0; mh < 4; mh += RESID_BATCH) {
                f32x4 bs[RESID_BATCH][2][2];
#pragma unroll
                for (int m = 0; m < RESID_BATCH; ++m) { const size_t ro = (size_t)(ai * HALF + (mh + m) * 16) * 2048;
#pragma unroll
                    for (int bj = 0; bj < 2; ++bj)
#pragma unroll
                        for (int n = 0; n < 2; ++n) bs[m][bj][n] = ld16f((const gf4*)(bp + ro + bj * HALF + n * 16)); }
#pragma unroll
                for (int m = 0; m < RESID_BATCH; ++m) { const size_t ro = (size_t)(ai * HALF + (mh + m) * 16) * 2048;
#pragma unroll
                    for (int bj = 0; bj < 2; ++bj)
#pragma unroll
                        for (int n = 0; n < 2; ++n) st16f((gf4*)(op + ro + bj * HALF + n * 16), bs[m][bj][n] + gv[bj][n] * acc[ai][bj][mh + m][n]); }
                asm volatile("" ::: "memory"); }
    }
};

struct EpiMerge1 {
    static constexpr bool PERM = true; static constexpr int IDEMP = 0; static constexpr bool PF = false;
    const gbf* Pg; int ldp; gbf* Z; int ldz;
    __device__ __forceinline__ void operator()(f32x4 (&acc)[2][2][4][2], const Unit& u, int wr, int wc, int fr, int fq) const {
        const int row0 = u.pm * BM + wr * 64 + fr, col0 = u.pn * BM + wc * 32 + 8 * fq;
        const bool fin = (u.flags & 2) != 0;
#pragma unroll
        for (int ai = 0; ai < 2; ++ai) {
            u32x4 pbv[4][2], pav[4][2];
#pragma unroll
            for (int m = 0; m < 4; ++m)
#pragma unroll
                for (int bj = 0; bj < 2; ++bj) { const gbf* gp = Pg + (size_t)(row0 + ai * HALF + m * 16) * ldp + col0 + bj * HALF;
                    pbv[m][bj] = *(const gu4*)(gp + 2048); if (!fin) pav[m][bj] = *(const gu4*)gp; }
#pragma unroll
            for (int m = 0; m < 4; ++m) { const size_t rrow = (size_t)(row0 + ai * HALF + m * 16);
#pragma unroll
                for (int bj = 0; bj < 2; ++bj) { const u32x4 pb = pbv[m][bj];
                    float gb[8]; gb[0] = bf_lo(pb.x); gb[1] = bf_hi(pb.x); gb[2] = bf_lo(pb.y); gb[3] = bf_hi(pb.y); gb[4] = bf_lo(pb.z); gb[5] = bf_hi(pb.z); gb[6] = bf_lo(pb.w); gb[7] = bf_hi(pb.w);
                    if (!fin) {
                        const u32x4 pa = pav[m][bj];
                        float ga[8]; ga[0] = bf_lo(pa.x); ga[1] = bf_hi(pa.x); ga[2] = bf_lo(pa.y); ga[3] = bf_hi(pa.y); ga[4] = bf_lo(pa.z); ga[5] = bf_hi(pa.z); ga[6] = bf_lo(pa.w); ga[7] = bf_hi(pa.w);
#pragma unroll
                        for (int e = 0; e < 8; ++e) {
                            const float ra = (1.0f + __builtin_amdgcn_exp2f(-1.4426950408889634f * gb[e])) * __builtin_amdgcn_rcpf(1.0f + __builtin_amdgcn_exp2f(-1.4426950408889634f * ga[e]));
                            acc[ai][bj][m][e >> 2][e & 3] *= ra; }
                    } else {
                        float z[8];
#pragma unroll
                        for (int e = 0; e < 8; ++e) z[e] = acc[ai][bj][m][e >> 2][e & 3] * fast_sigmoid(gb[e]);
                        u32x4 w; w.x = cvt_pk_bf16(z[0], z[1]); w.y = cvt_pk_bf16(z[2], z[3]); w.z = cvt_pk_bf16(z[4], z[5]); w.w = cvt_pk_bf16(z[6], z[7]);
                        st16((gu4*)(Z + rrow * ldz + col0 + bj * HALF), w); } } }
        }
    }
};
}
namespace att {
typedef unsigned short bf16_t;
using bf16x8 = __attribute__((ext_vector_type(8))) short;
using s16x4  = __attribute__((ext_vector_type(4))) short;
using f32x16 = __attribute__((ext_vector_type(16))) float;
using u32x4  = __attribute__((ext_vector_type(4))) unsigned;
#define ATT_LAS __attribute__((address_space(3)))
#define ATT_GAS __attribute__((address_space(1)))
typedef ATT_GAS unsigned short gbf; typedef ATT_GAS bf16x8 gbf8;
constexpr int   D = 128, NW = 8, QBLK = 32, KVBLK = 64, LDP = 10240;
constexpr float SCALE = 0.088388347648318440f;
constexpr float THR = 8.f;
constexpr int SHM_V = KVBLK * D * 2, SHM_K = KVBLK * D * 2, SHM_ATTN = 2 * SHM_V + 2 * SHM_K + NW * 64 * 4;
constexpr int TBL_OFF = SHM_ATTN, TBL_BYTES = 15 * 128 * 4;
constexpr int ST_OFF = TBL_OFF + TBL_BYTES, ST_PITCH = 272, ST_WAVE = 32 * ST_PITCH, ATT_LDS_BYTES = ST_OFF + NW * ST_WAVE;
#define KSWZ(row, colB) ((row) * 256 + ((colB) ^ (((row) & 7) << 4)))
#define SBAR() __builtin_amdgcn_sched_barrier(0)
__device__ __forceinline__ int crow(int r, int hi) { return (r & 3) + 8 * (r >> 2) + 4 * hi; }
__device__ __forceinline__ unsigned cvtpk(float lo, float hi) { unsigned r; asm volatile("v_cvt_pk_bf16_f32 %0, %1, %2" : "=v"(r) : "v"(lo), "v"(hi)); return r; }

#ifndef ATT_NOMAX
#define ATT_NOMAX 0
#endif
__device__ __forceinline__ void partialSM(f32x16& p0, f32x16& p1, float& m_reg, float& mn, float& alpha) {
  constexpr float C = SCALE * 1.4426950408889634f;
#if ATT_NOMAX
  mn = 0.f; alpha = 1.f;
#pragma unroll
  for (int r = 0; r < 16; ++r) p0[r] = __builtin_amdgcn_exp2f(fminf(p0[r] * C, 100.f));
#pragma unroll
  for (int r = 0; r < 16; ++r) p1[r] = fminf(p1[r] * C, 100.f);
  return;
#endif
  float pmax = p0[0];
#pragma unroll
  for (int r = 1; r < 16; ++r) pmax = fmaxf(pmax, p0[r]);
#pragma unroll
  for (int r = 0; r < 16; ++r) pmax = fmaxf(pmax, p1[r]);
  { auto rr = __builtin_amdgcn_permlane32_swap(__float_as_uint(pmax), __float_as_uint(pmax), false, false);
    pmax = fmaxf(__uint_as_float(rr[0]), __uint_as_float(rr[1])); }
  if (__builtin_expect(__all(pmax - m_reg <= THR / SCALE), 1)) { mn = m_reg; alpha = 1.f; }
  else { mn = fmaxf(m_reg, pmax); alpha = __builtin_amdgcn_exp2f((m_reg - mn) * C); m_reg = mn; }
  float mnC = -mn * C;
#pragma unroll
  for (int r = 0; r < 16; ++r) p0[r] = fmaf(p0[r], C, mnC);
#pragma unroll
  for (int r = 0; r < 16; ++r) p1[r] = fmaf(p1[r], C, mnC);
#pragma unroll
  for (int r = 0; r < 16; ++r) p0[r] = __builtin_amdgcn_exp2f(p0[r]);
}
__device__ __forceinline__ void finishSM(f32x16& p0, f32x16& p1, float alpha, float& l_reg, bf16x8& pa0, bf16x8& pa1, bf16x8& pa2, bf16x8& pa3) {
#pragma unroll
  for (int r = 0; r < 16; ++r) p1[r] = __builtin_amdgcn_exp2f(p1[r]);
  float ps = 0;
#pragma unroll
  for (int r = 0; r < 16; ++r) ps += p0[r];
#pragma unroll
  for (int r = 0; r < 16; ++r) ps += p1[r];
  { auto rr = __builtin_amdgcn_permlane32_swap(__float_as_uint(ps), __float_as_uint(ps), false, false);
    ps = __uint_as_float(rr[0]) + __uint_as_float(rr[1]); }
  l_reg = l_reg * alpha + ps;
#define PK4(P, BASE, OUT) do { unsigned a0 = cvtpk(P[BASE + 0], P[BASE + 1]), a1 = cvtpk(P[BASE + 2], P[BASE + 3]);   \
    unsigned b0 = cvtpk(P[BASE + 4], P[BASE + 5]), b1 = cvtpk(P[BASE + 6], P[BASE + 7]);                              \
    auto r0 = __builtin_amdgcn_permlane32_swap(a0, b0, false, false); auto r1 = __builtin_amdgcn_permlane32_swap(a1, b1, false, false); \
    u32x4 w = {r0[0], r1[0], r0[1], r1[1]}; OUT = *reinterpret_cast<bf16x8*>(&w); } while (0)
  PK4(p0, 0, pa0); PK4(p0, 8, pa1); PK4(p1, 0, pa2); PK4(p1, 8, pa3);
#undef PK4
}
__device__ __forceinline__ void qkt(f32x16& p0, f32x16& p1, const char* Ks, const bf16x8* qr, int r32, int hi) {
#ifdef ATT_PROBE_QK2
  p0 = f32x16{}; p1 = f32x16{};
#pragma unroll
  for (int d0 = 0; d0 < 8; ++d0) { int cb = (d0 * 16 + hi * 8) * 2;
    bf16x8 b0 = *reinterpret_cast<const bf16x8*>(Ks + KSWZ(r32, cb));
    bf16x8 b1 = *reinterpret_cast<const bf16x8*>(Ks + KSWZ(32 + r32, cb));
    p0 = __builtin_amdgcn_mfma_f32_32x32x16_bf16(b0, qr[d0], p0, 0, 0, 0);
    p1 = __builtin_amdgcn_mfma_f32_32x32x16_bf16(b1, qr[d0], p1, 0, 0, 0); }
  asm volatile("" : "+v"(p0), "+v"(p1));
#endif
  p0 = f32x16{}; p1 = f32x16{};
#pragma unroll
  for (int d0 = 0; d0 < 8; ++d0) { int cb = (d0 * 16 + hi * 8) * 2;
    bf16x8 b0 = *reinterpret_cast<const bf16x8*>(Ks + KSWZ(r32, cb));
    bf16x8 b1 = *reinterpret_cast<const bf16x8*>(Ks + KSWZ(32 + r32, cb));
    p0 = __builtin_amdgcn_mfma_f32_32x32x16_bf16(b0, qr[d0], p0, 0, 0, 0);
    p1 = __builtin_amdgcn_mfma_f32_32x32x16_bf16(b1, qr[d0], p1, 0, 0, 0); }
}
__device__ __forceinline__ int v_st(int k, int c) { const int kk = (k & ~0xC) | ((k & 4) << 1) | ((k & 8) >> 1); return ((kk >> 3) * 4 + (c >> 5)) * 512 + ((kk & 7) * 32 + (c & 31)) * 2; }
__device__ __forceinline__ int v_rd_base(int lane) { return ((lane & 3) << 3) | (((lane >> 2) & 3) << 6) | (((lane >> 4) & 1) << 5) | (((lane >> 5) & 1) << 8); }
constexpr int v_rd_off(int d0, int ks, int half) { return d0 * 512 + ks * 4096 + half * 2048; }
template <int OFF> __device__ __forceinline__ s16x4 tr_read(int vb) {
  s16x4 r; asm volatile("ds_read_b64_tr_b16 %0, %1 offset:%2" : "=&v"(r) : "v"(vb), "i"(OFF) : "memory"); return r;
}
template <int D0> __device__ __forceinline__ void pv_one(f32x16& od, int vb, bf16x8 pa0, bf16x8 pa1, bf16x8 pa2, bf16x8 pa3) {
  const s16x4 l0 = tr_read<v_rd_off(D0, 0, 0)>(vb), h0 = tr_read<v_rd_off(D0, 0, 1)>(vb), l1 = tr_read<v_rd_off(D0, 1, 0)>(vb), h1 = tr_read<v_rd_off(D0, 1, 1)>(vb);
  const s16x4 l2 = tr_read<v_rd_off(D0, 2, 0)>(vb), h2 = tr_read<v_rd_off(D0, 2, 1)>(vb), l3 = tr_read<v_rd_off(D0, 3, 0)>(vb), h3 = tr_read<v_rd_off(D0, 3, 1)>(vb);
  asm volatile("s_waitcnt lgkmcnt(0)" ::: "memory"); SBAR();
#define PK(L, H) (bf16x8){L[0], L[1], L[2], L[3], H[0], H[1], H[2], H[3]}
  od = __builtin_amdgcn_mfma_f32_32x32x16_bf16(pa0, PK(l0, h0), od, 0, 0, 0);
  od = __builtin_amdgcn_mfma_f32_32x32x16_bf16(pa1, PK(l1, h1), od, 0, 0, 0);
  od = __builtin_amdgcn_mfma_f32_32x32x16_bf16(pa2, PK(l2, h2), od, 0, 0, 0);
  od = __builtin_amdgcn_mfma_f32_32x32x16_bf16(pa3, PK(l3, h3), od, 0, 0, 0);
#undef PK
}
__device__ __forceinline__ void pv_d0(f32x16* o, int vb, bf16x8 pa0, bf16x8 pa1, bf16x8 pa2, bf16x8 pa3) {
  pv_one<0>(o[0], vb, pa0, pa1, pa2, pa3); pv_one<1>(o[1], vb, pa0, pa1, pa2, pa3); pv_one<2>(o[2], vb, pa0, pa1, pa2, pa3); pv_one<3>(o[3], vb, pa0, pa1, pa2, pa3);
}

struct Unit {
  const gbf* Q;
  const gbf* K0; const gbf* K1; int n0; int dv; int NT;
  gbf* O; int ldo;
  int r0, kr_lo, ntl;
};

template <bool NA>
__device__ __forceinline__ void na_bias(f32x16& p0, f32x16& p1, int j, const Unit& u, int rgrid, int rs, int cs, int hi, const float* lrow) {
  if constexpr (NA) {
    if (j >= u.n0) {
      const int jl = j - u.n0, kr = u.kr_lo + jl;
      if (jl < u.ntl && (unsigned)(kr - rs) < 8u) {
        const float* row = lrow + (kr - rgrid + 7) * 128;
#pragma unroll
        for (int g = 0; g < 4; ++g) {
          float b0[4], b1[4];
#pragma unroll
          for (int q = 0; q < 4; ++q) { const int cr = q + 8 * g; b0[q] = row[cr]; b1[q] = row[cr + 32]; }
#pragma unroll
          for (int q = 0; q < 4; ++q) { const int r = 4 * g + q, kc = q + 8 * g + 4 * hi;
            p0[r] = ((unsigned)(kc - cs) < 16u) ? p0[r] + b0[q] : -1e30f;
            p1[r] = ((unsigned)(kc + 32 - cs) < 16u) ? p1[r] + b1[q] : -1e30f; }
          asm volatile("" ::: "memory");
        }
      } else {
#pragma unroll
        for (int r = 0; r < 16; ++r) { p0[r] = -1e30f; p1[r] = -1e30f; }
      }
    }
  }
}

template <bool NA, int SD>
__device__ __forceinline__ void attn_unit(const Unit& u, char* lds) {
  int tid_ = threadIdx.x; asm volatile("" : "+v"(tid_));
  const int tid = tid_, wid = __builtin_amdgcn_readfirstlane(tid >> 6), lane = tid & 63, r32 = lane & 31, hi = lane >> 5;
  char* V_lds = lds; char* K_lds = lds + 2 * SHM_V;
  float* ws = (float*)(lds + 2 * SHM_V + 2 * SHM_K) + wid * 64; float* li_l = ws; float* al_l = ws + 32;
  float m_reg = -1e30f, l_reg = 0; f32x16 o[4] = {}; bf16x8 qr[8];
  const gbf* Qw = u.Q + (long)(wid * QBLK + r32) * LDP + hi * 8;
#pragma unroll
  for (int d0 = 0; d0 < 8; ++d0) qr[d0] = *(const gbf8*)(Qw + d0 * 16);
  const int sr = tid >> 4, sc = (tid & 15) * 8, vst0 = v_st(sr, sc), vst1 = v_st(32 + sr, sc);
  const int vb0 = (int)(uintptr_t)V_lds + v_rd_base(lane);
  const int rgrid = u.r0 + (wid >> 1), rs = rgrid - 4 < 0 ? 0 : (rgrid - 4 > 24 ? 24 : rgrid - 4);
  const int qc = (wid & 1) * 32 + r32, cs = qc - 8 < 0 ? 0 : (qc - 8 > 48 ? 48 : qc - 8);
  const float* lrow = (const float*)(lds + TBL_OFF) + (48 + 4 * hi - qc + 15);
  struct { bf16x8 vs0, vs1, ks0, ks1; } sr_[SD];
#define KTILE(j) ((j) < u.n0 ? u.K0 + (size_t)(j) * (KVBLK * LDP) : u.K1 + (size_t)((j) - u.n0) * (KVBLK * LDP))
#define SLOAD(i, j) do { const gbf* kt_ = KTILE(j) + (size_t)sr * LDP + sc; \
    sr_[i].vs0 = *(const gbf8*)(kt_ + u.dv); sr_[i].vs1 = *(const gbf8*)(kt_ + u.dv + 32 * LDP); \
    sr_[i].ks0 = *(const gbf8*)(kt_); sr_[i].ks1 = *(const gbf8*)(kt_ + 32 * LDP); } while (0)
#define SWRITE(b, i) do { *(bf16x8*)(V_lds + (b) * SHM_V + vst0) = sr_[i].vs0;          \
    *(bf16x8*)(V_lds + (b) * SHM_V + vst1) = sr_[i].vs1; int kc_ = sc * 2;               \
    *(bf16x8*)(K_lds + (b) * SHM_K + KSWZ(sr, kc_)) = sr_[i].ks0;                       \
    *(bf16x8*)(K_lds + (b) * SHM_K + KSWZ(32 + sr, kc_)) = sr_[i].ks1; } while (0)
#define SWAIT() do { if constexpr (SD == 2) asm volatile("s_waitcnt vmcnt(4)" ::: "memory"); else asm volatile("s_waitcnt vmcnt(0)" ::: "memory"); } while (0)
#define RESC(a) do { if (__any((a) < 1.f)) { if (hi == 0) al_l[r32] = (a); asm volatile("s_waitcnt lgkmcnt(0)" ::: "memory"); \
    _Pragma("unroll") for (int d = 0; d < 4; ++d) _Pragma("unroll") for (int r = 0; r < 16; ++r) o[d][r] *= al_l[crow(r, hi)]; } } while (0)
  f32x16 pA0, pA1, pB0, pB1; float mnA, mnB, alA, alB; bf16x8 pa0, pa1, pa2, pa3; const int NT = u.NT;
  constexpr int SE = 0, SO = SD - 1;
  SLOAD(SE, 0); asm volatile("s_waitcnt vmcnt(0)" ::: "memory"); SWRITE(0, SE); __syncthreads();
  qkt(pA0, pA1, K_lds, qr, r32, hi); na_bias<NA>(pA0, pA1, 0, u, rgrid, rs, cs, hi, lrow); partialSM(pA0, pA1, m_reg, mnA, alA);
  SLOAD(SO, 1); if constexpr (SD == 2) { if (2 < NT) SLOAD(SE, 2); }
  SWAIT(); SWRITE(1, SO); __syncthreads();
  for (int j = 1; j + 1 < NT; j += 2) {
    SBAR(); qkt(pB0, pB1, K_lds + SHM_K, qr, r32, hi);
    finishSM(pA0, pA1, alA, l_reg, pa0, pa1, pa2, pa3); SBAR();
    SLOAD(SO, j + SD); SBAR();
    pv_d0(o, vb0, pa0, pa1, pa2, pa3); na_bias<NA>(pB0, pB1, j, u, rgrid, rs, cs, hi, lrow); partialSM(pB0, pB1, m_reg, mnB, alB);
    __syncthreads(); SWAIT(); SWRITE(0, SE);
    RESC(alB); __syncthreads();
    SBAR(); qkt(pA0, pA1, K_lds, qr, r32, hi);
    finishSM(pB0, pB1, alB, l_reg, pa0, pa1, pa2, pa3); SBAR();
    if (SD == 1 || j + 3 < NT) SLOAD(SE, j + 1 + SD); SBAR();
    pv_d0(o, vb0 + SHM_V, pa0, pa1, pa2, pa3); na_bias<NA>(pA0, pA1, j + 1, u, rgrid, rs, cs, hi, lrow); partialSM(pA0, pA1, m_reg, mnA, alA);
    __syncthreads(); SWAIT(); SWRITE(1, SO);
    RESC(alA); __syncthreads();
  }
  SBAR(); qkt(pB0, pB1, K_lds + SHM_K, qr, r32, hi);
  finishSM(pA0, pA1, alA, l_reg, pa0, pa1, pa2, pa3); SBAR();
  pv_d0(o, vb0, pa0, pa1, pa2, pa3); na_bias<NA>(pB0, pB1, NT - 1, u, rgrid, rs, cs, hi, lrow); partialSM(pB0, pB1, m_reg, mnB, alB);
  __syncthreads(); RESC(alB);
  finishSM(pB0, pB1, alB, l_reg, pa0, pa1, pa2, pa3); SBAR();
  pv_d0(o, vb0 + SHM_V, pa0, pa1, pa2, pa3);
  if (hi == 0) li_l[r32] = l_reg; asm volatile("s_waitcnt lgkmcnt(0)" ::: "memory");
  float rli[16];
#pragma unroll
  for (int r = 0; r < 16; ++r) rli[r] = __builtin_amdgcn_rcpf(li_l[crow(r, hi)]);
  char* st = lds + ST_OFF + wid * ST_WAVE;
#pragma unroll
  for (int r = 0; r < 16; ++r) { const int orow = crow(r, hi);
#pragma unroll
    for (int d0 = 0; d0 < 4; ++d0) { const float v = o[d0][r] * rli[r]; unsigned b = __float_as_uint(v); b = (b + 0x7fffu + ((b >> 16) & 1u)) >> 16;
      *(bf16_t*)(st + orow * ST_PITCH + (d0 * 32 + r32) * 2) = (bf16_t)b; } }
  asm volatile("s_waitcnt lgkmcnt(0)" ::: "memory");
  gbf* Ow = u.O + (long)(wid * QBLK) * u.ldo;
#pragma unroll
  for (int q = 0; q < 8; ++q) { const int idx = q * 64 + lane, orow = idx >> 4, ch = idx & 15;
    const u32x4 w = *(const u32x4*)(st + orow * ST_PITCH + ch * 16);
    *(ATT_GAS u32x4*)(Ow + (long)orow * u.ldo + ch * 8) = w; }
  asm volatile("s_waitcnt lgkmcnt(0)" ::: "memory");
#undef KTILE
#undef SLOAD
#undef SWRITE
#undef SWAIT
#undef RESC
}

template <int D0> __device__ __forceinline__ void pv_one_b(f32x16& od, const ATT_LAS char* vp, bf16x8 pa0, bf16x8 pa1, bf16x8 pa2, bf16x8 pa3) {
#define TRB(off) __builtin_amdgcn_ds_read_tr16_b64_v4i16((ATT_LAS s16x4*)(vp + (off)))
  const s16x4 l0 = TRB(v_rd_off(D0, 0, 0)), h0 = TRB(v_rd_off(D0, 0, 1)), l1 = TRB(v_rd_off(D0, 1, 0)), h1 = TRB(v_rd_off(D0, 1, 1));
  const s16x4 l2 = TRB(v_rd_off(D0, 2, 0)), h2 = TRB(v_rd_off(D0, 2, 1)), l3 = TRB(v_rd_off(D0, 3, 0)), h3 = TRB(v_rd_off(D0, 3, 1));
#undef TRB
#define PK(L, H) (bf16x8){L[0], L[1], L[2], L[3], H[0], H[1], H[2], H[3]}
  od = __builtin_amdgcn_mfma_f32_32x32x16_bf16(pa0, PK(l0, h0), od, 0, 0, 0);
  od = __builtin_amdgcn_mfma_f32_32x32x16_bf16(pa1, PK(l1, h1), od, 0, 0, 0);
  od = __builtin_amdgcn_mfma_f32_32x32x16_bf16(pa2, PK(l2, h2), od, 0, 0, 0);
  od = __builtin_amdgcn_mfma_f32_32x32x16_bf16(pa3, PK(l3, h3), od, 0, 0, 0);
#undef PK
}
__device__ __forceinline__ void pv_d0_b(f32x16* o, const ATT_LAS char* vp, bf16x8 pa0, bf16x8 pa1, bf16x8 pa2, bf16x8 pa3) {
  pv_one_b<0>(o[0], vp, pa0, pa1, pa2, pa3); pv_one_b<1>(o[1], vp, pa0, pa1, pa2, pa3); pv_one_b<2>(o[2], vp, pa0, pa1, pa2, pa3); pv_one_b<3>(o[3], vp, pa0, pa1, pa2, pa3);
}
#ifndef ATT_WPV
#define ATT_WPV 0
#endif
#ifndef ATT_WQK
#define ATT_WQK 0
#endif
#ifndef ATT_WPROBE
#define ATT_WPROBE 0
#endif
__device__ __forceinline__ void qkt_w(f32x16& p0, f32x16& p1, const ATT_LAS char* Kb, const int* ka, const bf16x8* qr) {
#define KLD(d0, up) (*(const ATT_LAS bf16x8*)(Kb + ka[(d0) & 3] + ((d0) >> 2) * 128 + (up) * 8192))
  p0 = f32x16{}; p1 = f32x16{};
  bf16x8 a0 = KLD(0, 0), a1 = KLD(0, 1), b0 = KLD(1, 0), b1 = KLD(1, 1);
#pragma unroll
  for (int d0 = 0; d0 < 8; d0 += 2) {
    p0 = __builtin_amdgcn_mfma_f32_32x32x16_bf16(a0, qr[d0], p0, 0, 0, 0);
    p1 = __builtin_amdgcn_mfma_f32_32x32x16_bf16(a1, qr[d0], p1, 0, 0, 0);
    if (d0 + 2 < 8) { a0 = KLD(d0 + 2, 0); a1 = KLD(d0 + 2, 1); }
    p0 = __builtin_amdgcn_mfma_f32_32x32x16_bf16(b0, qr[d0 + 1], p0, 0, 0, 0);
    p1 = __builtin_amdgcn_mfma_f32_32x32x16_bf16(b1, qr[d0 + 1], p1, 0, 0, 0);
    if (d0 + 3 < 8) { b0 = KLD(d0 + 3, 0); b1 = KLD(d0 + 3, 1); }
  }
  __builtin_amdgcn_sched_group_barrier(0x100, 4, 0);
#pragma unroll
  for (int i = 0; i < 6; ++i) { __builtin_amdgcn_sched_group_barrier(0x008, 2, 0); __builtin_amdgcn_sched_group_barrier(0x100, 2, 0); }
  __builtin_amdgcn_sched_group_barrier(0x008, 4, 0);
#undef KLD
}
struct VF { s16x4 l0, h0, l1, h1, l2, h2, l3, h3; };
template <int DB> __device__ __forceinline__ void pvw_read(VF& f, int vb) {
  constexpr int B = (DB >> 2) * SHM_V, D0 = DB & 3;
  f.l0 = tr_read<B + v_rd_off(D0, 0, 0)>(vb); f.h0 = tr_read<B + v_rd_off(D0, 0, 1)>(vb); f.l1 = tr_read<B + v_rd_off(D0, 1, 0)>(vb); f.h1 = tr_read<B + v_rd_off(D0, 1, 1)>(vb);
  f.l2 = tr_read<B + v_rd_off(D0, 2, 0)>(vb); f.h2 = tr_read<B + v_rd_off(D0, 2, 1)>(vb); f.l3 = tr_read<B + v_rd_off(D0, 3, 0)>(vb); f.h3 = tr_read<B + v_rd_off(D0, 3, 1)>(vb);
}
__device__ __forceinline__ void pvw_mma(f32x16& od, const VF& f, bf16x8 pa0, bf16x8 pa1, bf16x8 pa2, bf16x8 pa3) {
#define PK(L, H) (bf16x8){L[0], L[1], L[2], L[3], H[0], H[1], H[2], H[3]}
  od = __builtin_amdgcn_mfma_f32_32x32x16_bf16(pa0, PK(f.l0, f.h0), od, 0, 0, 0);
  od = __builtin_amdgcn_mfma_f32_32x32x16_bf16(pa1, PK(f.l1, f.h1), od, 0, 0, 0);
  od = __builtin_amdgcn_mfma_f32_32x32x16_bf16(pa2, PK(f.l2, f.h2), od, 0, 0, 0);
  od = __builtin_amdgcn_mfma_f32_32x32x16_bf16(pa3, PK(f.l3, f.h3), od, 0, 0, 0);
#undef PK
}
__device__ __forceinline__ void pv_wide8(f32x16* o, int vb, bf16x8 pa0, bf16x8 pa1, bf16x8 pa2, bf16x8 pa3) {
  VF fa, fb;
#define W8() do { asm volatile("s_waitcnt lgkmcnt(8)" ::: "memory"); SBAR(); } while (0)
  pvw_read<0>(fa, vb);
  pvw_read<1>(fb, vb); W8(); pvw_mma(o[0], fa, pa0, pa1, pa2, pa3); SBAR();
  pvw_read<2>(fa, vb); W8(); pvw_mma(o[1], fb, pa0, pa1, pa2, pa3); SBAR();
  pvw_read<3>(fb, vb); W8(); pvw_mma(o[2], fa, pa0, pa1, pa2, pa3); SBAR();
  pvw_read<4>(fa, vb); W8(); pvw_mma(o[3], fb, pa0, pa1, pa2, pa3); SBAR();
  pvw_read<5>(fb, vb); W8(); pvw_mma(o[4], fa, pa0, pa1, pa2, pa3); SBAR();
  pvw_read<6>(fa, vb); W8(); pvw_mma(o[5], fb, pa0, pa1, pa2, pa3); SBAR();
  pvw_read<7>(fb, vb); W8(); pvw_mma(o[6], fa, pa0, pa1, pa2, pa3); SBAR();
  asm volatile("s_waitcnt lgkmcnt(0)" ::: "memory"); SBAR(); pvw_mma(o[7], fb, pa0, pa1, pa2, pa3);
#undef W8
}
constexpr int W_K = 0, W_V = 2 * SHM_K, W_VBUF = 2 * SHM_V, W_WS = W_V + 2 * W_VBUF, W_LDS_BYTES = W_WS + NW * 64 * 4;
__device__ __forceinline__ void attn_wide_unit(const Unit& u, char* lds) {
  int tid_ = threadIdx.x; asm volatile("" : "+v"(tid_));
  const int tid = tid_, wid = __builtin_amdgcn_readfirstlane(tid >> 6), lane = tid & 63, r32 = lane & 31, hi = lane >> 5;
  float* ws = (float*)(lds + W_WS) + wid * 64; float* li_l = ws; float* al_l = ws + 32;
  float m_reg = -1e30f, l_reg = 0; f32x16 o[8] = {}; bf16x8 qr[8];
  const gbf* Qw = u.Q + (long)(wid * QBLK + r32) * LDP + hi * 8;
#pragma unroll
  for (int d0 = 0; d0 < 8; ++d0) qr[d0] = *(const gbf8*)(Qw + d0 * 16);
  const int kr0 = wid * 8 + (lane >> 4);
  const unsigned offK0 = (unsigned)(kr0 * LDP + (((lane & 15) ^ (lane >> 4)) * 8)), offK1 = (unsigned)((kr0 + 4) * LDP + (((lane & 15) ^ (4 + (lane >> 4))) * 8));
  const int vkk = wid * 8 + ((lane & 31) >> 2), vk = (vkk & ~0xC) | ((vkk & 4) << 1) | ((vkk & 8) >> 1);
  const unsigned offV = (unsigned)(vk * LDP + (lane >> 5) * 32 + (lane & 3) * 8);
  const int vb0 = (int)(uintptr_t)(lds + W_V) + v_rd_base(lane);
  ATT_LAS unsigned char* l3 = (ATT_LAS unsigned char*)lds;
  const ATT_LAS char* vp0 = (const ATT_LAS char*)l3 + W_V + v_rd_base(lane);
  int ka[4];
#pragma unroll
  for (int dd = 0; dd < 4; ++dd) ka[dd] = r32 * 256 + ((dd * 32 + hi * 16) ^ ((r32 & 7) << 4));
#define KTILE(j) ((j) < u.n0 ? u.K0 + (size_t)(j) * (KVBLK * LDP) : u.K1 + (size_t)((j) - u.n0) * (KVBLK * LDP))
#define WDMA(gp, loff) __builtin_amdgcn_global_load_lds((const ATT_GAS unsigned*)(gp), (ATT_LAS unsigned*)(l3 + (loff)), 16, 0, 0)
#define WISSUE(j, b) do { const gbf* kt_ = KTILE(j); const gbf* vt_ = kt_ + u.dv + offV; \
    WDMA(kt_ + offK0, W_K + (b) * SHM_K + wid * 2048); WDMA(kt_ + offK1, W_K + (b) * SHM_K + wid * 2048 + 1024); \
    WDMA(vt_, W_V + (b) * W_VBUF + wid * 2048); WDMA(vt_ + 64, W_V + (b) * W_VBUF + wid * 2048 + 1024); \
    WDMA(vt_ + 128, W_V + (b) * W_VBUF + SHM_V + wid * 2048); WDMA(vt_ + 192, W_V + (b) * W_VBUF + SHM_V + wid * 2048 + 1024); } while (0)
#define WRESC(a) do { if (__any((a) < 1.f)) { if (hi == 0) al_l[r32] = (a); asm volatile("s_waitcnt lgkmcnt(0)" ::: "memory"); \
    _Pragma("unroll") for (int d = 0; d < 8; ++d) _Pragma("unroll") for (int r = 0; r < 16; ++r) o[d][r] *= al_l[crow(r, hi)]; } } while (0)
#define WSTEP(j, b) do { f32x16 p0, p1; float mn, al; bf16x8 pa0, pa1, pa2, pa3; \
    if ((j) + 1 < NT) WISSUE((j) + 1, 1 - (b)); \
    if (ATT_WPROBE == 1) { qkt_w(p0, p1, (const ATT_LAS char*)l3 + W_K + (b) * SHM_K, ka, qr); asm volatile("" : "+v"(p0), "+v"(p1)); } \
    if (ATT_WQK) qkt_w(p0, p1, (const ATT_LAS char*)l3 + W_K + (b) * SHM_K, ka, qr); else qkt(p0, p1, lds + W_K + (b) * SHM_K, qr, r32, hi); partialSM(p0, p1, m_reg, mn, al); WRESC(al); finishSM(p0, p1, al, l_reg, pa0, pa1, pa2, pa3); SBAR(); \
    if (ATT_WPROBE == 2) { pv_wide8(o, vb0 + (b) * W_VBUF, pa0, pa1, pa2, pa3); _Pragma("unroll") for (int i_ = 0; i_ < 8; ++i_) asm volatile("" : "+v"(o[i_])); \
      bf16x8 n0 = pa0 ^ (short)0x8000, n1 = pa1 ^ (short)0x8000, n2 = pa2 ^ (short)0x8000, n3 = pa3 ^ (short)0x8000; pv_wide8(o, vb0 + (b) * W_VBUF, n0, n1, n2, n3); _Pragma("unroll") for (int i_ = 0; i_ < 8; ++i_) asm volatile("" : "+v"(o[i_])); } \
    if (ATT_WPV == 2) pv_wide8(o, vb0 + (b) * W_VBUF, pa0, pa1, pa2, pa3); \
    else if (ATT_WPV) { pv_d0_b(o, vp0 + (b) * W_VBUF, pa0, pa1, pa2, pa3); pv_d0_b(o + 4, vp0 + (b) * W_VBUF + SHM_V, pa0, pa1, pa2, pa3); } \
    else { pv_d0(o, vb0 + (b) * W_VBUF, pa0, pa1, pa2, pa3); pv_d0(o + 4, vb0 + (b) * W_VBUF + SHM_V, pa0, pa1, pa2, pa3); } \
    asm volatile("s_waitcnt vmcnt(0)" ::: "memory"); __syncthreads(); } while (0)
  const int NT = u.NT;
#ifndef ATT_WPRIO
#define ATT_WPRIO 0
#endif
  if (ATT_WPRIO && wid < 4) __builtin_amdgcn_s_setprio(ATT_WPRIO);
  __syncthreads();
  WISSUE(0, 0); asm volatile("s_waitcnt vmcnt(0)" ::: "memory"); __syncthreads();
  for (int j = 0; j < NT; j += 2) { WSTEP(j, 0); WSTEP(j + 1, 1); }
  if (ATT_WPRIO) __builtin_amdgcn_s_setprio(0);
  if (hi == 0) li_l[r32] = l_reg; asm volatile("s_waitcnt lgkmcnt(0)" ::: "memory");
  float rli[16];
#pragma unroll
  for (int r = 0; r < 16; ++r) rli[r] = __builtin_amdgcn_rcpf(li_l[crow(r, hi)]);
  char* st = lds + wid * ST_WAVE;
  gbf* Ow = u.O + (long)(wid * QBLK) * u.ldo;
#pragma unroll
  for (int h = 0; h < 2; ++h) {
#pragma unroll
    for (int r = 0; r < 16; ++r) { const int orow = crow(r, hi);
#pragma unroll
      for (int d0 = 0; d0 < 4; ++d0) { const float v = o[4 * h + d0][r] * rli[r]; unsigned b = __float_as_uint(v); b = (b + 0x7fffu + ((b >> 16) & 1u)) >> 16;
        *(bf16_t*)(st + orow * ST_PITCH + (d0 * 32 + r32) * 2) = (bf16_t)b; } }
    asm volatile("s_waitcnt lgkmcnt(0)" ::: "memory");
#pragma unroll
    for (int q = 0; q < 8; ++q) { const int idx = q * 64 + lane, orow = idx >> 4, ch = idx & 15;
      const u32x4 w = *(const u32x4*)(st + orow * ST_PITCH + ch * 16);
      *(ATT_GAS u32x4*)(Ow + (long)orow * u.ldo + h * 128 + ch * 8) = w; }
    asm volatile("s_waitcnt lgkmcnt(0)" ::: "memory");
  }
#undef KTILE
#undef WDMA
#undef WISSUE
#undef WRESC
#undef WSTEP
}

constexpr int P_K = 0, P_V = 2 * SHM_K, P_VBUF = 2 * SHM_V, P_WS = P_V + 3 * P_VBUF, P_LDS_BYTES = P_WS + NW * 64 * 4;
__device__ __forceinline__ void attn_wide_pp(const Unit& u, char* lds) {
  int tid_ = threadIdx.x; asm volatile("" : "+v"(tid_));
  const int tid = tid_, wid = __builtin_amdgcn_readfirstlane(tid >> 6), lane = tid & 63, r32 = lane & 31, hi = lane >> 5, grp = wid >> 2;
  float* ws = (float*)(lds + P_WS) + wid * 64; float* li_l = ws; float* al_l = ws + 32;
  float m_reg = -1e30f, l_reg = 0; f32x16 o[8] = {}; bf16x8 qr[8];
  const gbf* Qw = u.Q + (long)(wid * QBLK + r32) * LDP + hi * 8;
#pragma unroll
  for (int d0 = 0; d0 < 8; ++d0) qr[d0] = *(const gbf8*)(Qw + d0 * 16);
  const int kr0 = wid * 8 + (lane >> 4);
  const unsigned offK0 = (unsigned)(kr0 * LDP + (((lane & 15) ^ (lane >> 4)) * 8)), offK1 = (unsigned)((kr0 + 4) * LDP + (((lane & 15) ^ (4 + (lane >> 4))) * 8));
  const int vkk = wid * 8 + ((lane & 31) >> 2), vk = (vkk & ~0xC) | ((vkk & 4) << 1) | ((vkk & 8) >> 1);
  const unsigned offV = (unsigned)(vk * LDP + (lane >> 5) * 32 + (lane & 3) * 8);
  const int vb0 = (int)(uintptr_t)(lds + P_V) + v_rd_base(lane);
  ATT_LAS unsigned char* l3 = (ATT_LAS unsigned char*)lds;
#define KTILE(j) ((j) < u.n0 ? u.K0 + (size_t)(j) * (KVBLK * LDP) : u.K1 + (size_t)((j) - u.n0) * (KVBLK * LDP))
#define WDMA(gp, loff) __builtin_amdgcn_global_load_lds((const ATT_GAS unsigned*)(gp), (ATT_LAS unsigned*)(l3 + (loff)), 16, 0, 0)
#define PISSUE(j, ko, vo) do { const gbf* kt_ = KTILE(j); const gbf* vt_ = kt_ + u.dv + offV; \
    WDMA(kt_ + offK0, P_K + (ko) + wid * 2048); WDMA(kt_ + offK1, P_K + (ko) + wid * 2048 + 1024); \
    WDMA(vt_, P_V + (vo) + wid * 2048); WDMA(vt_ + 64, P_V + (vo) + wid * 2048 + 1024); \
    WDMA(vt_ + 128, P_V + (vo) + SHM_V + wid * 2048); WDMA(vt_ + 192, P_V + (vo) + SHM_V + wid * 2048 + 1024); } while (0)
#define WRESC(a) do { if (__any((a) < 1.f)) { if (hi == 0) al_l[r32] = (a); asm volatile("s_waitcnt lgkmcnt(0)" ::: "memory"); \
    _Pragma("unroll") for (int d = 0; d < 8; ++d) _Pragma("unroll") for (int r = 0; r < 16; ++r) o[d][r] *= al_l[crow(r, hi)]; } } while (0)
  const int NT = u.NT;
  f32x16 p0, p1; float mn, al; bf16x8 pa0 = {}, pa1 = {}, pa2 = {}, pa3 = {};
  int kb = 0, vm = 2 * P_VBUF, v0 = 0, vn = P_VBUF;
  __syncthreads();
  PISSUE(0, 0, 0); asm volatile("s_waitcnt vmcnt(0)" ::: "memory"); __syncthreads();
#pragma unroll 1
  for (int j = 0; j < NT; ++j) {
    if (j + 1 < NT) PISSUE(j + 1, kb ^ SHM_K, vn);
    if (grp == 1 && j > 0) { pv_d0(o, vb0 + vm, pa0, pa1, pa2, pa3); pv_d0(o + 4, vb0 + vm + SHM_V, pa0, pa1, pa2, pa3); SBAR(); }
    qkt(p0, p1, lds + P_K + kb, qr, r32, hi); partialSM(p0, p1, m_reg, mn, al); WRESC(al); finishSM(p0, p1, al, l_reg, pa0, pa1, pa2, pa3); SBAR();
    if (grp == 0) { pv_d0(o, vb0 + v0, pa0, pa1, pa2, pa3); pv_d0(o + 4, vb0 + v0 + SHM_V, pa0, pa1, pa2, pa3); }
    asm volatile("s_waitcnt vmcnt(0)" ::: "memory"); __syncthreads();
    kb ^= SHM_K; { const int t_ = vm; vm = v0; v0 = vn; vn = t_; }
  }
  if (grp == 1) { pv_d0(o, vb0 + vm, pa0, pa1, pa2, pa3); pv_d0(o + 4, vb0 + vm + SHM_V, pa0, pa1, pa2, pa3); }
  __syncthreads();
  if (hi == 0) li_l[r32] = l_reg; asm volatile("s_waitcnt lgkmcnt(0)" ::: "memory");
  float rli[16];
#pragma unroll
  for (int r = 0; r < 16; ++r) rli[r] = __builtin_amdgcn_rcpf(li_l[crow(r, hi)]);
  char* st = lds + wid * ST_WAVE;
  gbf* Ow = u.O + (long)(wid * QBLK) * u.ldo;
#pragma unroll
  for (int h = 0; h < 2; ++h) {
#pragma unroll
    for (int r = 0; r < 16; ++r) { const int orow = crow(r, hi);
#pragma unroll
      for (int d0 = 0; d0 < 4; ++d0) { const float v = o[4 * h + d0][r] * rli[r]; unsigned b = __float_as_uint(v); b = (b + 0x7fffu + ((b >> 16) & 1u)) >> 16;
        *(bf16_t*)(st + orow * ST_PITCH + (d0 * 32 + r32) * 2) = (bf16_t)b; } }
    asm volatile("s_waitcnt lgkmcnt(0)" ::: "memory");
#pragma unroll
    for (int q = 0; q < 8; ++q) { const int idx = q * 64 + lane, orow = idx >> 4, ch = idx & 15;
      const u32x4 w = *(const u32x4*)(st + orow * ST_PITCH + ch * 16);
      *(ATT_GAS u32x4*)(Ow + (long)orow * u.ldo + h * 128 + ch * 8) = w; }
    asm volatile("s_waitcnt lgkmcnt(0)" ::: "memory");
  }
#undef KTILE
#undef WDMA
#undef PISSUE
#undef WRESC
}
constexpr int D_K = 0, D_V = 3 * SHM_K, D_WS = D_V + 3 * SHM_V, D_TBL = D_WS + NW * 64 * 4, D_LDS_BYTES = D_TBL + TBL_BYTES;
template <bool NA>
__device__ __forceinline__ void attn_dma_unit(const Unit& u, char* lds) {
  int tid_ = threadIdx.x; asm volatile("" : "+v"(tid_));
  const int tid = tid_, wid = __builtin_amdgcn_readfirstlane(tid >> 6), lane = tid & 63, r32 = lane & 31, hi = lane >> 5;
  float* ws = (float*)(lds + D_WS) + wid * 64; float* li_l = ws; float* al_l = ws + 32;
  float m_reg = -1e30f, l_reg = 0; f32x16 o[4] = {}; bf16x8 qr[8];
  const gbf* Qw = u.Q + (long)(wid * QBLK + r32) * LDP + hi * 8;
#pragma unroll
  for (int d0 = 0; d0 < 8; ++d0) qr[d0] = *(const gbf8*)(Qw + d0 * 16);
  const int kr0 = wid * 8 + (lane >> 4);
  const unsigned offK0 = (unsigned)(kr0 * LDP + (((lane & 15) ^ (lane >> 4)) * 8)), offK1 = (unsigned)((kr0 + 4) * LDP + (((lane & 15) ^ (4 + (lane >> 4))) * 8));
  const int vkk = wid * 8 + ((lane & 31) >> 2), vk = (vkk & ~0xC) | ((vkk & 4) << 1) | ((vkk & 8) >> 1);
  const unsigned offV = (unsigned)(vk * LDP + (lane >> 5) * 32 + (lane & 3) * 8);
  const int vb0 = (int)(uintptr_t)(lds + D_V) + v_rd_base(lane);
  ATT_LAS unsigned char* l3 = (ATT_LAS unsigned char*)lds;
  const int rgrid = u.r0 + (wid >> 1), rs = rgrid - 4 < 0 ? 0 : (rgrid - 4 > 24 ? 24 : rgrid - 4);
  const int qc = (wid & 1) * 32 + r32, cs = qc - 8 < 0 ? 0 : (qc - 8 > 48 ? 48 : qc - 8);
  const float* lrow = (const float*)(lds + D_TBL) + (48 + 4 * hi - qc + 15);
#define KTILE(j) ((j) < u.n0 ? u.K0 + (size_t)(j) * (KVBLK * LDP) : u.K1 + (size_t)((j) - u.n0) * (KVBLK * LDP))
#define WDMA(gp, loff) __builtin_amdgcn_global_load_lds((const ATT_GAS unsigned*)(gp), (ATT_LAS unsigned*)(l3 + (loff)), 16, 0, 0)
#define DISSUE(j, bo) do { const gbf* kt_ = KTILE(j); const gbf* vt_ = kt_ + u.dv + offV; \
    WDMA(kt_ + offK0, D_K + (bo) + wid * 2048); WDMA(kt_ + offK1, D_K + (bo) + wid * 2048 + 1024); \
    WDMA(vt_, D_V + (bo) + wid * 2048); WDMA(vt_ + 64, D_V + (bo) + wid * 2048 + 1024); } while (0)
#define DRESC(a) do { if (__any((a) < 1.f)) { if (hi == 0) al_l[r32] = (a); asm volatile("s_waitcnt lgkmcnt(0)" ::: "memory"); \
    _Pragma("unroll") for (int d = 0; d < 4; ++d) _Pragma("unroll") for (int r = 0; r < 16; ++r) o[d][r] *= al_l[crow(r, hi)]; } } while (0)
  f32x16 pA0, pA1, pB0, pB1; float mnA, mnB, alA, alB; bf16x8 pa0, pa1, pa2, pa3; const int NT = u.NT;
  int b0 = 0, b1 = SHM_K, b2 = 2 * SHM_K;
  __syncthreads();
  DISSUE(0, b0); DISSUE(1, b1);
  asm volatile("s_waitcnt vmcnt(4)" ::: "memory"); __syncthreads();
  qkt(pA0, pA1, lds + D_K + b0, qr, r32, hi); na_bias<NA>(pA0, pA1, 0, u, rgrid, rs, cs, hi, lrow); partialSM(pA0, pA1, m_reg, mnA, alA);
  asm volatile("s_waitcnt vmcnt(0)" ::: "memory"); __syncthreads();
#define DVALID(j) (!NA || (j) < u.n0 || (((j) - u.n0) < u.ntl && (unsigned)(u.kr_lo + ((j) - u.n0) - rs) < 8u))
  bool vA = true, vB;
  for (int j = 0; j < NT; j += 2) {
    if (j + 2 < NT) DISSUE(j + 2, b2);
    vB = DVALID(j + 1);
    if (vB) { SBAR(); qkt(pB0, pB1, lds + D_K + b1, qr, r32, hi); }
    if (vA) { finishSM(pA0, pA1, alA, l_reg, pa0, pa1, pa2, pa3); SBAR();
      pv_d0(o, vb0 + b0, pa0, pa1, pa2, pa3); }
    if (vB) { na_bias<NA>(pB0, pB1, j + 1, u, rgrid, rs, cs, hi, lrow); partialSM(pB0, pB1, m_reg, mnB, alB);
      DRESC(alB); }
    asm volatile("s_waitcnt vmcnt(0)" ::: "memory"); __syncthreads();
    if (j + 3 < NT) DISSUE(j + 3, b0);
    vA = (j + 2 < NT) && DVALID(j + 2);
    if (vA) { SBAR(); qkt(pA0, pA1, lds + D_K + b2, qr, r32, hi); }
    if (vB) { finishSM(pB0, pB1, alB, l_reg, pa0, pa1, pa2, pa3); SBAR();
      pv_d0(o, vb0 + b1, pa0, pa1, pa2, pa3); }
    if (vA) { na_bias<NA>(pA0, pA1, j + 2, u, rgrid, rs, cs, hi, lrow); partialSM(pA0, pA1, m_reg, mnA, alA); DRESC(alA); }
    asm volatile("s_waitcnt vmcnt(0)" ::: "memory"); __syncthreads();
    { const int t_ = b0; b0 = b2; b2 = b1; b1 = t_; }
  }
#undef DVALID
  if (hi == 0) li_l[r32] = l_reg; asm volatile("s_waitcnt lgkmcnt(0)" ::: "memory");
  float rli[16];
#pragma unroll
  for (int r = 0; r < 16; ++r) rli[r] = __builtin_amdgcn_rcpf(li_l[crow(r, hi)]);
  char* st = lds + wid * ST_WAVE;
#pragma unroll
  for (int r = 0; r < 16; ++r) { const int orow = crow(r, hi);
#pragma unroll
    for (int d0 = 0; d0 < 4; ++d0) { const float v = o[d0][r] * rli[r]; unsigned b = __float_as_uint(v); b = (b + 0x7fffu + ((b >> 16) & 1u)) >> 16;
      *(bf16_t*)(st + orow * ST_PITCH + (d0 * 32 + r32) * 2) = (bf16_t)b; } }
  asm volatile("s_waitcnt lgkmcnt(0)" ::: "memory");
  gbf* Ow = u.O + (long)(wid * QBLK) * u.ldo;
#pragma unroll
  for (int q = 0; q < 8; ++q) { const int idx = q * 64 + lane, orow = idx >> 4, ch = idx & 15;
    const u32x4 w = *(const u32x4*)(st + orow * ST_PITCH + ch * 16);
    *(ATT_GAS u32x4*)(Ow + (long)orow * u.ldo + ch * 8) = w; }
  asm volatile("s_waitcnt lgkmcnt(0)" ::: "memory");
#undef KTILE
#undef WDMA
#undef DISSUE
#undef DRESC
}
#undef KSWZ
#undef SBAR
}
constexpr int NWAVES = 8;
constexpr int DM = 2048, NBATCH = 8, SEQ = 2048, NLAYER = 2, CTXL = 256;
constexpr int ML = NBATCH * SEQ, MC = NBATCH * CTXL, MT = ML + MC;
constexpr int DFF = 5632, DIN = 10240, QA_OFF = 4096, QB_OFF = 5120, G_OFF = 6144;
constexpr int MODW = 9 * DM;
#ifndef PAD_H
#define PAD_H 64
#endif
#ifndef PAD_U
#define PAD_U 64
#endif
constexpr int LDH = DM + PAD_H, LDU = DFF + PAD_U;
constexpr float EPS = 1e-6f;
constexpr int N_IN = 26;
enum { IN_X = 0, IN_C, IN_CTX, IN_CCTX, IN_ADAW, IN_ADAB, IN_N1G, IN_F1W1, IN_F1W3, IN_F1W2, IN_N2G, IN_WIN, IN_RPB, IN_LQ1, IN_LK1, IN_LQ2, IN_LK2, IN_SUBG, IN_WPA, IN_WPB, IN_WO, IN_N3G, IN_F2W1, IN_F2W3, IN_F2W2, IN_FG };

constexpr size_t MiB = 1u << 20;
constexpr size_t WS_CTL = 0, CTL_ZERO_BYTES = 1 * MiB;
constexpr size_t WS_MISC = 1 * MiB;
constexpr size_t WS_ROPE = 2 * MiB;
constexpr size_t WS_MOD = 3 * MiB;
constexpr size_t WS_W = 8 * MiB;
constexpr size_t WL_13A = 0, WL_2A = 46 * MiB, WL_13B = 69 * MiB, WL_2B = 115 * MiB, WL_IN = 138 * MiB, WL_PAB = 180 * MiB, WL_O = 189 * MiB, WL_SIZE = 198 * MiB;
constexpr size_t WS_X = WS_W + 2 * WL_SIZE;
constexpr size_t WS_P = WS_X + 144 * MiB;
constexpr size_t WS_Y = WS_P + 360 * MiB;
constexpr size_t WS_H = WS_Y + 75 * MiB;
constexpr size_t WS_DBG = WS_H + 75 * MiB;
constexpr size_t WS_END = WS_DBG + 8 * MiB;
static_assert(WL_13A + (size_t)2 * DFF * LDH * 2 <= WL_2A && WL_2A + (size_t)DM * LDU * 2 <= WL_13B && WL_13B + (size_t)2 * DFF * LDH * 2 <= WL_2B && WL_2B + (size_t)DM * LDU * 2 <= WL_IN && WL_IN + (size_t)DIN * LDH * 2 <= WL_PAB && WL_PAB + (size_t)DM * LDH * 2 <= WL_O && WL_O + (size_t)DM * LDH * 2 <= WL_SIZE, "weight map");
static_assert((size_t)MT * DM * 4 <= 144 * MiB && (size_t)MT * DIN * 2 <= 360 * MiB && (size_t)MT * LDU * 2 <= 360 * MiB && (size_t)MT * LDH * 2 <= 75 * MiB, "activation map");
constexpr int CW_TMO = 0, CW_CODE = 1, CW_BAR = 4096, CW_DBG = 16384;

constexpr int RING_OFF = 0, RING_BYTES = 131072;
constexpr int LDS_BYTES = 147456;
constexpr int LDSCTL_OFF = LDS_BYTES - 512, MISC_OFF = LDSCTL_OFF;
static_assert(att::ATT_LDS_BYTES <= LDSCTL_OFF && att::W_LDS_BYTES <= LDSCTL_OFF && att::P_LDS_BYTES <= LDSCTL_OFF && att::D_LDS_BYTES <= LDSCTL_OFF && att::NW * att::ST_WAVE <= att::D_WS && att::NW * att::ST_WAVE <= att::W_WS, "attention LDS map");

#define GAS __attribute__((address_space(1)))
#define LAS __attribute__((address_space(3)))
typedef unsigned short bf16;
typedef unsigned v4u __attribute__((ext_vector_type(4)));
typedef unsigned v2u __attribute__((ext_vector_type(2)));
typedef float f32x4 __attribute__((ext_vector_type(4)));
typedef GAS unsigned gu32;
#define RLX_AGENT __ATOMIC_RELAXED, __HIP_MEMORY_SCOPE_AGENT
#define LDS_WAIT() asm volatile("s_waitcnt lgkmcnt(0)" ::: "memory")
#define VM_WAIT() asm volatile("s_waitcnt vmcnt(0)" ::: "memory")
__device__ __forceinline__ unsigned f2bf(float f) { unsigned u = __builtin_bit_cast(unsigned, f); return (u + 0x7fffu + ((u >> 16) & 1u)) >> 16; }
__device__ __forceinline__ unsigned pk2(float lo, float hi) { return pg8::cvt_pk_bf16(lo, hi); }
__device__ __forceinline__ float bf2f(unsigned short v) { return __uint_as_float((unsigned)v << 16); }

#define XB_TMO      128
#define XB_XCNT(j)  (256  + 64 * (j))
#define XB_XSUB(j)  (1280 + 64 * (j))
#define XB_XGEN(j)  (2304 + 64 * (j))
#define XB_TOP      3328
#define XB_TOPGEN   3392
#define XCD_BAR_WORDS 3456
#define XB_SPIN_CAP (1u << 20)
__device__ __forceinline__ unsigned xb_ld(unsigned* p)              { return __hip_atomic_load(p, __ATOMIC_RELAXED, __HIP_MEMORY_SCOPE_AGENT); }
__device__ __forceinline__ unsigned xb_add(unsigned* p, unsigned v) { return __hip_atomic_fetch_add(p, v, __ATOMIC_RELAXED, __HIP_MEMORY_SCOPE_AGENT); }
__device__ __forceinline__ unsigned xb_xcc_id() { return (unsigned)__builtin_amdgcn_s_getreg((3 << 11) | 20) & 0xFu; }
#define XB_SPIN(cond, bar) do { unsigned _sp = 0; while (cond) { __builtin_amdgcn_s_sleep(1); \
    if ((++_sp & 255u) == 0u) { if (xb_ld(&(bar)[XB_TMO])) break; if (_sp > XB_SPIN_CAP) { atomicAdd(&(bar)[XB_TMO], 1u); break; } } } } while (0)
struct XcdBarrier { unsigned* bar; unsigned x; volatile LAS unsigned* st; };
__device__ __forceinline__ XcdBarrier xcd_barrier_post(unsigned* bar, volatile LAS unsigned* st) {
    XcdBarrier b; b.bar = bar; b.x = xb_xcc_id(); b.st = st;
    if (threadIdx.x == 0) (void)xb_add(&bar[XB_XCNT(b.x)], 1u);
    return b;
}
__device__ __forceinline__ void xcd_barrier_complete(unsigned* bar, unsigned x, unsigned& nloc, unsigned& nx) {
    const unsigned G = gridDim.x * gridDim.y * gridDim.z;
    unsigned sum, cnt, mine, sp = 0u;
    for (;;) {
        sum = 0u; cnt = 0u; mine = 0u;
#pragma unroll
        for (unsigned j = 0; j < 16; ++j) { const unsigned c = xb_ld(&bar[XB_XCNT(j)]); sum += c; cnt += (c > 0u) ? 1u : 0u; mine = (j == x) ? c : mine; }
        if (sum == G) break;
        __builtin_amdgcn_s_sleep(1);
        if ((++sp & 255u) == 0u) { if (xb_ld(&bar[XB_TMO])) break; if (sp > XB_SPIN_CAP) { atomicAdd(&bar[XB_TMO], 1u); break; } }
    }
    nloc = mine > 0u ? mine : 1u; nx = cnt > 0u ? cnt : 1u;
}
__device__ __forceinline__ void xcd_barrier(const XcdBarrier& b) {
    asm volatile("s_waitcnt vmcnt(0)" ::: "memory");
    __syncthreads();
    if (threadIdx.x == 0) {
        unsigned* bar = b.bar;
        __builtin_amdgcn_s_waitcnt(0);
        unsigned nloc = b.st[0], nx = b.st[1];
        if (nloc == 0u) { xcd_barrier_complete(bar, b.x, nloc, nx); b.st[0] = nloc; b.st[1] = nx; }
        const unsigned old = xb_add(&bar[XB_XSUB(b.x)], 1u);
        const unsigned gen = old / nloc;
        if (old + 1u == (gen + 1u) * nloc) {
            __builtin_amdgcn_fence(__ATOMIC_RELEASE, "agent");
            asm volatile("s_waitcnt vmcnt(0)" ::: "memory");
            const unsigned og = xb_add(&bar[XB_TOP], 1u);
            const unsigned tg = og / nx;
            if (og + 1u == (tg + 1u) * nx) xb_add(&bar[XB_TOPGEN], 1u);
            else XB_SPIN(xb_ld(&bar[XB_TOPGEN]) == tg, bar);
            __builtin_amdgcn_fence(__ATOMIC_ACQUIRE, "agent");
            xb_add(&bar[XB_XGEN(b.x)], 1u);
            asm volatile("s_waitcnt vmcnt(0)" ::: "memory");
        } else {
            XB_SPIN(xb_ld(&bar[XB_XGEN(b.x)]) == gen, bar);
            __builtin_amdgcn_fence(__ATOMIC_ACQUIRE, "agent");
            asm volatile("s_waitcnt vmcnt(0)" ::: "memory");
        }
    }
    __syncthreads();
}

__device__ __forceinline__ float wave_sum(float v) {
#pragma unroll
    for (int o = 1; o < 64; o <<= 1) v += __shfl_xor(v, o);
    return v;
}

__host__ __device__ __forceinline__ int w13_row(int j, int is3) { return 256 * (j >> 7) + 128 * ((j >> 2) & 1) + 32 * ((j >> 5) & 3) + 16 * is3 + 4 * ((j >> 3) & 3) + (j & 3); }
__host__ __device__ __forceinline__ int win_row(int j) {
    if (!((j >= 2048 && j < 3072) || (j >= 5120 && j < 6144))) return j;
    const int d = j & 127, a = d >> 6, h = (d >> 5) & 1, f = d & 31;
    return (j & ~127) + 32 * (2 * a + (f >> 4)) + 8 * ((f >> 2) & 3) + 4 * h + (f & 3);
}
__device__ __forceinline__ void tr_item(const GAS float* W, int N, int k0, int n0, GAS bf16* WT, int ldk, int koff, int mode, LAS float* scr, int lane) {
    f32x4 v[16];
    const GAS f32x4* src = (const GAS f32x4*)(W + (size_t)(k0 + (lane >> 4)) * N + n0 + 4 * (lane & 15));
#pragma unroll
    for (int i = 0; i < 16; ++i) v[i] = __builtin_nontemporal_load(src + (size_t)i * N);
#pragma unroll
    for (int i = 0; i < 16; ++i) { LAS float* d = scr + (4 * i + (lane >> 4)) * 65 + 4 * (lane & 15); d[0] = v[i].x; d[1] = v[i].y; d[2] = v[i].z; d[3] = v[i].w; }
    LDS_WAIT(); asm volatile("" ::: "memory");
    const int c = lane & 7;
#pragma unroll
    for (int j = 0; j < 8; ++j) { const int n = (lane >> 3) + 8 * j; const LAS float* s = scr + (8 * c) * 65 + n;
        v4u o; o.x = pk2(s[0 * 65], s[1 * 65]); o.y = pk2(s[2 * 65], s[3 * 65]); o.z = pk2(s[4 * 65], s[5 * 65]); o.w = pk2(s[6 * 65], s[7 * 65]);
        const int col = n0 + n, row = mode == 0 ? col : (mode == 3 ? win_row(col) : w13_row(col, mode - 1));
        __builtin_nontemporal_store(o, (GAS v4u*)(WT + (size_t)row * ldk + koff + k0 + 8 * c)); }
    LDS_WAIT(); asm volatile("" ::: "memory");
}
__device__ __forceinline__ void norm_row(const GAS float* xrow, const GAS float* g, const GAS float* shift, const GAS float* scale, GAS bf16* hrow,
                                         const GAS float* sl, const GAS float* gate, float gs, GAS float* xw, int lane) {
    const GAS f32x4* xr = (const GAS f32x4*)xrow + lane;
    const GAS f32x4* gp = (const GAS f32x4*)g + lane; const GAS f32x4* shp = (const GAS f32x4*)shift + lane; const GAS f32x4* scp = (const GAS f32x4*)scale + lane;
    f32x4 v[8], gs8[8], sh8[8]; float ss = 0.f;
#pragma unroll
    for (int j = 0; j < 8; ++j) v[j] = xr[64 * j];
#pragma unroll
    for (int j = 0; j < 8; ++j) { gs8[j] = gp[64 * j] * (scp[64 * j] + 1.0f); sh8[j] = shp[64 * j]; }
    if (sl) {
        const GAS v2u* s0 = (const GAS v2u*)sl + lane; const GAS f32x4* gt = (const GAS f32x4*)gate + lane; GAS f32x4* xo = (GAS f32x4*)xw + lane;
#pragma unroll
        for (int j = 0; j < 8; ++j) { f32x4 p = (f32x4){0.f, 0.f, 0.f, 0.f};
#pragma unroll
            for (int q = 0; q < 4; ++q) { const v2u w = s0[64 * j + q * (2048 * 2048 / 4)]; p.x += pg8::bf_lo(w.x); p.y += pg8::bf_hi(w.x); p.z += pg8::bf_lo(w.y); p.w += pg8::bf_hi(w.y); }
            v[j] = v[j] + gt[64 * j] * gs * p; xo[64 * j] = v[j]; }
    }
#pragma unroll
    for (int j = 0; j < 8; ++j) ss += (v[j].x * v[j].x + v[j].y * v[j].y) + (v[j].z * v[j].z + v[j].w * v[j].w);
    const float rstd = 1.0f / sqrtf(wave_sum(ss) * (1.0f / DM) + EPS);
    GAS v2u* o8 = (GAS v2u*)hrow + lane;
#pragma unroll
    for (int j = 0; j < 8; ++j) { const f32x4 y = v[j] * rstd * gs8[j] + sh8[j];
        v2u w; w.x = pk2(y.x, y.y); w.y = pk2(y.z, y.w); o8[64 * j] = w; }
}

constexpr int CV_F = 32 * 88, CV_IN = 32 * 160, CV_P = 16 * 32, CV_O = 32 * 32, CV_A = 3 * CV_F, CV_M = CV_IN + 2 * CV_P + CV_O, CV_L = 2 * CV_A + CV_M, CV_TOTAL = 2 * CV_L;
#define GIN(k) ((const GAS float*)args.in[k])
#ifndef CV_Q0
#define CV_Q0 CV_A
#endif
constexpr int CW_Q = 8192;
struct Args;
__device__ __forceinline__ void conv_item(const Args& args, GAS unsigned char* ws, int it, LAS float* scr, int lane);
struct Args { const float* in[N_IN]; float* out; unsigned char* ws; int ph_lo, ph_hi; };

__device__ __forceinline__ void conv_item(const Args& args, GAS unsigned char* ws, int it, LAS float* scr, int lane) {
    const int l = it / CV_L; int r = it % CV_L;
    GAS unsigned char* wl = ws + WS_W + (size_t)l * WL_SIZE;
    int f = 0;
    if (r >= CV_A && r < CV_A + CV_M) {
        r -= CV_A;
        if (r < CV_IN) { tr_item(GIN(IN_WIN) + (size_t)l * DM * DIN, DIN, 64 * (r / 160), 64 * (r % 160), (GAS bf16*)(wl + WL_IN), LDH, 0, 3, scr, lane); return; }
        r -= CV_IN;
        if (r < 2 * CV_P) { const int which = r / CV_P, idx = r % CV_P;
            tr_item(GIN(IN_WPA + which) + (size_t)l * 1024 * DM, DM, 64 * (idx / 32), 64 * (idx % 32), (GAS bf16*)(wl + WL_PAB), LDH, 1024 * which, 0, scr, lane); return; }
        r -= 2 * CV_P;
        tr_item(GIN(IN_WO) + (size_t)l * DM * DM, DM, 64 * (r / 32), 64 * (r % 32), (GAS bf16*)(wl + WL_O), LDH, 0, 0, scr, lane); return; }
    if (r >= CV_A) { r -= CV_A + CV_M; f = 1; }
    const int mat = r / CV_F, idx = r % CV_F;
    if (mat < 2) { const GAS float* W = GIN((f == 0 ? IN_F1W1 : IN_F2W1) + mat) + (size_t)l * DM * DFF;
        tr_item(W, DFF, 64 * (idx / 88), 64 * (idx % 88), (GAS bf16*)(wl + (f == 0 ? WL_13A : WL_13B)), LDH, 0, 1 + mat, scr, lane); }
    else { const GAS float* W = GIN(f == 0 ? IN_F1W2 : IN_F2W2) + (size_t)l * DFF * DM;
        tr_item(W, DM, 64 * (idx / 32), 64 * (idx % 32), (GAS bf16*)(wl + (f == 0 ? WL_2A : WL_2B)), LDU, 0, 0, scr, lane); }
}
__device__ __forceinline__ void conv_fill(const Args& args, GAS unsigned char* ws, LAS unsigned char* lds, volatile LAS unsigned* MISC, int max_pops, int need, int wave, int lane) {
    gu32* qh = (gu32*)(ws + WS_CTL) + CW_Q;
    LAS float* scr = (LAS float*)(lds + wave * (64 * 65 * 4));
    for (int p = 0; need > 0 || p < max_pops; ++p) {
        __syncthreads();
        if (threadIdx.x == 0) { unsigned b;
            if (need > 0 && (int)(CV_Q0 + __hip_atomic_load(qh, RLX_AGENT)) >= need) b = 0x7fffffffu; else b = __hip_atomic_fetch_add(qh, 16u, RLX_AGENT);
            MISC[16] = b; }
        __syncthreads();
        const unsigned b = MISC[16];
        if (b >= (unsigned)(CV_TOTAL - CV_Q0)) break;
#pragma unroll 1
        for (int q = 0; q < 2; ++q) { const int it = CV_Q0 + (int)b + 2 * wave + q; if (it < CV_TOTAL) conv_item(args, ws, it, scr, lane); }
        if (need > 0 && CV_Q0 + (int)b + 16 >= need) break;
    }
    __syncthreads();
}
constexpr int N_PHASES = 24;
#ifndef PH_MASK
#define PH_MASK 0xFFFFFF
#endif
#ifndef WGM_UP
#define WGM_UP 4
#endif
#ifndef WGM_DOWN
#define WGM_DOWN 4
#endif
#ifndef WGM_IN
#define WGM_IN 4
#endif
#ifndef WGM_M1
#define WGM_M1 4
#endif
#ifndef WGM_M2
#define WGM_M2 4
#endif
#ifndef ATT_WIDE
#define ATT_WIDE 1
#endif
#ifndef ATT_DMA
#define ATT_DMA 1
#endif
#ifndef ATT_WPP
#define ATT_WPP 0
#endif
#ifndef ROT_DOWN
#define ROT_DOWN 0
#endif
#ifndef NA_SD
#define NA_SD 1
#endif
#ifndef FILL_UP
#define FILL_UP 4
#endif
#ifndef FILL_IN
#define FILL_IN 4
#endif
#ifndef FILL_M1
#define FILL_M1 6
#endif

__global__ void __launch_bounds__(NWAVES * 64, 2) mega_fwd(Args args) {
    extern __shared__ __attribute__((aligned(16))) unsigned char lds_raw[];
    LAS unsigned char* lds = (LAS unsigned char*)lds_raw;
    volatile LAS unsigned* MISC = (volatile LAS unsigned*)(lds + MISC_OFF);
    const int tid0 = threadIdx.x;
    for (int u = tid0; u < (LDS_BYTES - LDSCTL_OFF) / 4; u += NWAVES * 64) ((LAS unsigned*)(lds + LDSCTL_OFF))[u] = 0u;
    __syncthreads();
    const int lo = args.ph_lo, hi = args.ph_hi;
    if (hi - lo > 1) (void)xcd_barrier_post((unsigned*)((gu32*)(args.ws + WS_CTL) + CW_BAR), MISC + 8);
    int ph = 0, li = 0;
#define IN_PH() (lo <= ph && ph < hi)
#define END_PH() do { if (ph + 1 < hi && lo <= ph) { XcdBarrier bar_; bar_.bar = (unsigned*)((gu32*)(args.ws + WS_CTL) + CW_BAR); bar_.x = xb_xcc_id(); bar_.st = MISC + 8; xcd_barrier(bar_); } ++ph; \
    asm volatile("" : "+s"(ph), "+s"(li)); } while (0)
#define PH_VIEWS() GAS unsigned char* ws = (GAS unsigned char*)args.ws; asm volatile("" : "+s"(ws)); const int G = gridDim.x, bx = blockIdx.x; int tid = threadIdx.x; asm volatile("" : "+v"(tid)); \
    const int lane = tid & 63, wave = __builtin_amdgcn_readfirstlane(tid >> 6); (void)lane; \
    const int vcu = (G % 8 == 0) ? (bx % 8) * (G / 8) + bx / 8 : bx; const int gw = vcu * NWAVES + wave, NGW = G * NWAVES; (void)gw; (void)NGW; \
    GAS float* miscf = (GAS float*)(ws + WS_MISC); GAS float* ropeC = (GAS float*)(ws + WS_ROPE); GAS float* ropeS = ropeC + 2048 * 64; GAS float* modv = (GAS float*)(ws + WS_MOD); GAS float* X = (GAS float*)(ws + WS_X); \
    GAS bf16* P = (GAS bf16*)(ws + WS_P); GAS bf16* U = P; GAS bf16* Y = (GAS bf16*)(ws + WS_Y); GAS bf16* H = (GAS bf16*)(ws + WS_H); GAS bf16* O = H; GAS bf16* Z = H; \
    (void)miscf; (void)ropeC; (void)ropeS; (void)modv; (void)X; (void)P; (void)U; (void)Y; (void)H; (void)O; (void)Z;
#define LI_VIEWS() const int l = li >> 1, f = li & 1; const bool ctx_on = (li < 3); const GAS float* modl = modv + (size_t)l * 9 * MODW; const GAS unsigned char* wl = ws + WS_W + (size_t)l * WL_SIZE; \
    const GAS float* xinL = (li == 0) ? GIN(IN_X) : X; const GAS float* xinC = (li == 0) ? GIN(IN_CTX) : X + (size_t)ML * DM; const bool ctx_q = (l == 0); \
    (void)f; (void)ctx_on; (void)modl; (void)wl; (void)xinL; (void)xinC; (void)ctx_q;

#ifndef P0_REP
#define P0_REP 1
#endif
    if (IN_PH() && (PH_MASK & 1)) for (int p0rep_ = 0; p0rep_ < P0_REP; ++p0rep_) {
        PH_VIEWS();
        __syncthreads();
        {
            LAS float* S = (LAS float*)lds;
            LAS float* PART = (LAS float*)(lds + 9 * 2048 * 4);
            const GAS float* cin = GIN(IN_C); const GAS float* ccx = GIN(IN_CCTX);
            for (int i = tid; i < 9 * 2048; i += NWAVES * 64) { const int r = i >> 11, k = i & 2047; const float v = r < 8 ? cin[r * 2048 + k] : ccx[k]; S[i] = v / (1.0f + __expf(-v)); }
            __syncthreads();
            for (int chunk = bx; chunk < 256; chunk += G) {
                const int l = chunk >> 7, n0 = (chunk & 127) * 144, col4 = tid % 36, kph = tid / 36;
                float acc[9][4];
#pragma unroll
                for (int r = 0; r < 9; ++r)
#pragma unroll
                    for (int e = 0; e < 4; ++e) acc[r][e] = 0.f;
                if (kph < 14) {
                    const GAS float* w = GIN(IN_ADAW) + (size_t)l * 2048 * MODW + n0 + 4 * col4;
#pragma unroll 4
                    for (int k = kph; k < 2048; k += 14) { const f32x4 wv = *(const GAS f32x4*)(w + (size_t)k * MODW);
#pragma unroll
                        for (int r = 0; r < 9; ++r) { const float s = S[r * 2048 + k]; acc[r][0] += s * wv.x; acc[r][1] += s * wv.y; acc[r][2] += s * wv.z; acc[r][3] += s * wv.w; } }
#pragma unroll
                    for (int r = 0; r < 9; ++r)
#pragma unroll
                        for (int e = 0; e < 4; ++e) PART[(kph * 9 + r) * 144 + 4 * col4 + e] = acc[r][e];
                }
                __syncthreads();
                for (int o = tid; o < 9 * 144; o += NWAVES * 64) { const int r = o / 144, cc = o % 144; float s = 0.f;
#pragma unroll
                    for (int q = 0; q < 14; ++q) s += PART[(q * 9 + r) * 144 + cc];
                    modv[((size_t)l * 9 + r) * MODW + n0 + cc] = s + GIN(IN_ADAB)[l * MODW + n0 + cc]; }
                __syncthreads();
            }
        }
        for (int i = bx * NWAVES * 64 + tid; i < 2048 * 64; i += G * NWAVES * 64) { const int t = i >> 6, a = (i >> 5) & 1, f = i & 31;
            const float pos = (float)(a == 0 ? (t >> 6) : (t & 63)); const float inv = powf(10000.0f, -(float)f * (1.0f / 32.0f)); const float ang = pos * inv;
            ropeC[i] = cosf(ang); ropeS[i] = sinf(ang); }
        if (bx == 0 && wave < 2) { const int l = wave;
            const GAS float* q1 = GIN(IN_LQ1) + l * 128; const GAS float* k1 = GIN(IN_LK1) + l * 128; const GAS float* q2 = GIN(IN_LQ2) + l * 128; const GAS float* k2 = GIN(IN_LK2) + l * 128;
            const float s1 = wave_sum(q1[lane] * k1[lane] + q1[lane + 64] * k1[lane + 64]), s2 = wave_sum(q2[lane] * k2[lane] + q2[lane + 64] * k2[lane + 64]);
            const float lam_init = l == 0 ? 0.2f : (0.8f - 0.6f * 0.7408182206817179f);
            if (lane == 0) miscf[l] = expf(s1) - expf(s2) + lam_init; }
        {
            LAS float* scr = (LAS float*)(lds + wave * (64 * 65 * 4));
            for (int it = gw; it < CV_Q0; it += NGW) conv_item(args, ws, it, scr, lane);
        }
    }
    END_PH();

    for (li = 0; li < 4; ++li) {
        if (IN_PH() && (PH_MASK & 2)) {
            PH_VIEWS(); LI_VIEWS();
            if (li > 0) conv_fill(args, ws, lds, MISC, 0, li == 1 ? CV_L : (li == 2 ? CV_L + CV_A : 2 * CV_L), wave, lane);
            const GAS float* g = GIN(f == 0 ? IN_N1G : IN_N3G) + l * DM; const int jsh = f == 0 ? 0 : 6;
            const int nrows = ctx_on ? MT : ML;
            const bool slab_on = (li == 1 || li == 2); const GAS float* sgate = modv + (size_t)8 * MODW + (li == 1 ? 5 : 8) * DM; const float sgs = li == 1 ? 1.0f : 0.5f;
            for (int row = gw; row < nrows; row += NGW) {
                const int r = row < ML ? row >> 11 : 8; const bool sl = slab_on && row >= ML;
                const GAS float* xrow = row < ML ? xinL + (size_t)row * DM : xinC + (size_t)(row - ML) * DM;
                const GAS float* shp = modl + (size_t)r * MODW + jsh * DM;
                norm_row(xrow, g, shp, shp + DM, H + (size_t)row * LDH, sl ? (const GAS float*)((const GAS bf16*)Y + (size_t)(row - ML) * DM) : nullptr, sgate, sgs, X + (size_t)row * DM, lane);
            }
        }
        END_PH();
        if (IN_PH() && (PH_MASK & 4)) {
            PH_VIEWS(); LI_VIEWS();
            pg8::Gemm g{H, (const GAS bf16*)(wl + (f == 0 ? WL_13A : WL_13B)), LDH};
            pg8::GridOrder S; S.init(ctx_on ? MT / 256 : ML / 256, 2 * DFF / 256, 0, 0, 0, 0, G, bx, 1, 0, DM / 64);
            S.wgm = WGM_UP; pg8::EpiSwiglu E{U, LDU};
            pg8::gemm_phase<pg8::EpiSwiglu, pg8::GridOrder>(lds + RING_OFF, g, S, E);
            if (S.idle_last()) conv_fill(args, ws, lds, MISC, FILL_UP, 0, wave, lane);
            if (CV_Q0 < CV_A && li == 0) conv_fill(args, ws, lds, MISC, 0, CV_A, wave, lane);
        }
        END_PH();
        if (IN_PH() && (PH_MASK & 8)) {
            PH_VIEWS(); LI_VIEWS();
            pg8::Gemm g{U, (const GAS bf16*)(wl + (f == 0 ? WL_2A : WL_2B)), LDU};
            pg8::GridOrder S; if (ctx_on) S.init(ML / 256, DM / 256, 0, MC / 256, DM / 256, ML / 256, G, bx, 1, 0, DFF / 64, 4, DFF / 256); else S.init(ML / 256, DM / 256, 0, 0, 0, 0, G, bx, 1, 0, DFF / 64);
            S.wgm = WGM_DOWN; if (ROT_DOWN) S.set_rot(ROT_DOWN >= 16 ? ((bx & (ROT_DOWN >> 4)) != 0) : (((bx >> 3) & (ROT_DOWN)) == (ROT_DOWN))); pg8::EpiResid E{xinL, xinC, X, modl, (f == 0 ? 2 : 8) * DM, 0.5f, ML, (GAS float*)Y};
            pg8::gemm_phase<pg8::EpiResid, pg8::GridOrder>(lds + RING_OFF, g, S, E);
        }
        END_PH();
        if (li & 1) continue;
        if (IN_PH() && (PH_MASK & 16)) {
            PH_VIEWS(); LI_VIEWS();
            conv_fill(args, ws, lds, MISC, 0, l * CV_L + CV_A + CV_M, wave, lane);
            const GAS float* g = GIN(IN_N2G) + l * DM;
            const GAS float* sgate = modl + (size_t)8 * MODW + 2 * DM;
            for (int row = gw; row < MT; row += NGW) {
                const int r = row < ML ? row >> 11 : 8; const bool sl = row >= ML;
                const GAS float* xrow = (sl && l == 0) ? GIN(IN_CTX) + (size_t)(row - ML) * DM : X + (size_t)row * DM;
                const GAS float* shp = modl + (size_t)r * MODW + 3 * DM;
                norm_row(xrow, g, shp, shp + DM, H + (size_t)row * LDH, sl ? (const GAS float*)((const GAS bf16*)Y + (size_t)(row - ML) * DM) : nullptr, sgate, 0.5f, X + (size_t)row * DM, lane);
            }
        }
        END_PH();
        if (IN_PH() && (PH_MASK & 32)) {
            PH_VIEWS(); LI_VIEWS();
            pg8::Gemm g{H, (const GAS bf16*)(wl + WL_IN), LDH};
            pg8::GridOrder S;
            if (ctx_q) S.init(MT / 256, DIN / 256, 0, 0, 0, 0, G, bx, 1, 0, DM / 64); else S.init(ML / 256, DIN / 256, 0, MC / 256, 4096 / 256, ML / 256, G, bx, 1, 0, DM / 64);
            S.wgm = WGM_IN; pg8::EpiInproj E{P, DIN, ropeC, ropeS, ML};
            pg8::gemm_phase<pg8::EpiInproj, pg8::GridOrder>(lds + RING_OFF, g, S, E);
            if (S.idle_last()) conv_fill(args, ws, lds, MISC, FILL_IN, 0, wave, lane);
        }
        END_PH();
        if (IN_PH() && (PH_MASK & 128)) {
            PH_VIEWS(); LI_VIEWS();
            char* alds = (char*)lds_raw;
            const float lam = miscf[l]; const float lam_init = l == 0 ? 0.2f : (0.8f - 0.6f * 0.7408182206817179f);
            const f32x4 sg = *((const GAS f32x4*)(GIN(IN_SUBG) + l * 256) + lane) * (1.0f - lam_init);
            const int nquad = (ctx_q && G != 256) ? 288 : 256;
            for (int dq = bx; dq < nquad + G; dq += G) {
                int d = dq; if (dq >= nquad) { if (!(ctx_q && G == 256 && ((bx >> 3) & 7) == 0 && dq < nquad + G)) break; d = 256 + (bx & 7) + 8 * (bx >> 6); }
                const bool isc = d >= 256; const int c = d & 255, b = c & 7, qb = (c >> 3) & 7, h = isc ? (c >> 3) : (c >> 6);
                const size_t q0 = isc ? (size_t)(ML + b * 256) : (size_t)(b * 2048 + 256 * qb);
#if ATT_WIDE
#ifndef ATT_WREP
#define ATT_WREP 1
#endif
#pragma unroll 1
                for (int t_ = 0; t_ < 2 * ATT_WREP; ++t_) { const int t = t_ & 1;
                    att::Unit u; u.Q = P + q0 * DIN + QB_OFF + h * 256 + t * 128;
                    if (isc) { u.K0 = P + q0 * DIN + 2048 + h * 256 + t * 128; u.K1 = u.K0; u.n0 = 4; u.NT = 4; }
                    else { u.K0 = P + (size_t)(b * 2048) * DIN + 2048 + h * 256 + t * 128; u.K1 = P + (size_t)(ML + b * 256) * DIN + 2048 + h * 256 + t * 128; u.n0 = 32; u.NT = 36; }
                    u.dv = 1024 - 128 * t; u.O = O + q0 * LDH + h * 512 + t * 256; u.ldo = LDH; u.r0 = 0; u.kr_lo = 0; u.ntl = 0;
                    if (ATT_WPP) att::attn_wide_pp(u, alds); else att::attn_wide_unit(u, alds); }
                __syncthreads();
#else
#pragma unroll 1
                for (int tv = 0; tv < 4; ++tv) { const int t = tv >> 1, vh = tv & 1;
                    att::Unit u; u.Q = P + q0 * DIN + QB_OFF + h * 256 + t * 128;
                    if (isc) { u.K0 = P + q0 * DIN + 2048 + h * 256 + t * 128; u.K1 = u.K0; u.n0 = 4; u.NT = 4; }
                    else { u.K0 = P + (size_t)(b * 2048) * DIN + 2048 + h * 256 + t * 128; u.K1 = P + (size_t)(ML + b * 256) * DIN + 2048 + h * 256 + t * 128; u.n0 = 32; u.NT = 36; }
                    u.dv = 1024 + 128 * (vh - t); u.O = O + q0 * LDH + h * 512 + t * 256 + vh * 128; u.ldo = LDH; u.r0 = 0; u.kr_lo = 0; u.ntl = 0;
                    att::attn_unit<false, 2>(u, alds); }
#endif
                asm volatile("s_waitcnt vmcnt(0)" ::: "memory");
#pragma unroll 1
                for (int i0 = 0; i0 < 32; i0 += 16) {
                    v2u a[16], bq[16];
#pragma unroll
                    for (int i = 0; i < 16; ++i) { const size_t row = q0 + wave * 32 + i0 + i; a[i] = __builtin_nontemporal_load((const GAS v2u*)(O + row * LDH + h * 512) + lane); bq[i] = __builtin_nontemporal_load((const GAS v2u*)(O + row * LDH + h * 512 + 256) + lane); }
                    f32x4 dd[16]; float ssq[16];
#pragma unroll
                    for (int i = 0; i < 16; ++i) { dd[i].x = pg8::bf_lo(a[i].x) - lam * pg8::bf_lo(bq[i].x); dd[i].y = pg8::bf_hi(a[i].x) - lam * pg8::bf_hi(bq[i].x); dd[i].z = pg8::bf_lo(a[i].y) - lam * pg8::bf_lo(bq[i].y); dd[i].w = pg8::bf_hi(a[i].y) - lam * pg8::bf_hi(bq[i].y);
                        ssq[i] = (dd[i].x * dd[i].x + dd[i].y * dd[i].y) + (dd[i].z * dd[i].z + dd[i].w * dd[i].w); }
#pragma unroll
                    for (int o = 1; o < 64; o <<= 1)
#pragma unroll
                        for (int i = 0; i < 16; ++i) ssq[i] += __shfl_xor(ssq[i], o);
#pragma unroll
                    for (int i = 0; i < 16; ++i) { const size_t row = q0 + wave * 32 + i0 + i; const float rstd = 1.0f / sqrtf(ssq[i] * (1.0f / 256.0f) + EPS);
                        const f32x4 y = dd[i] * rstd * sg; v2u w; w.x = pk2(y.x, y.y); w.y = pk2(y.z, y.w);
                        *((GAS v2u*)(Y + row * LDH + 1024 + h * 256) + lane) = w; }
                }
            }
#ifndef ATT_REBAL
#define ATT_REBAL 0
#endif
            const bool rebal = ATT_REBAL && ctx_q && G == 256; const int rgw = (bx >> 3) & 7;
            if (ctx_q) for (int s0 = (G == 256 ? (rebal ? (rgw == 3 ? 1 : 0) : 0) : bx); s0 < (G == 256 ? (rebal ? (rgw == 7 ? 1 : (rgw == 3 ? 2 : 0)) : ((rgw == 7) ? 2 : 0)) : 64); s0 += (G == 256 ? 1 : G)) {
                att::Unit u; u.n0 = 4; u.NT = 4; u.ldo = LDH; u.r0 = 0; u.kr_lo = 0; u.ntl = 0;
                const int s = G == 256 ? (bx & 7) + 8 * ((bx >> 6) + 4 * s0) : s0; const int b = s & 7, h = s >> 3; const size_t r0 = (size_t)(ML + b * 256);
                u.Q = P + r0 * DIN + QA_OFF + h * 128; u.K0 = P + r0 * DIN + h * 128; u.K1 = u.K0; u.dv = 1024; u.O = Y + r0 * LDH + h * 128;
                if (ATT_DMA) att::attn_dma_unit<false>(u, alds); else att::attn_unit<false, 2>(u, alds);
            }
#ifndef NA_REP
#define NA_REP 1
#endif
            if (PH_MASK & 0x40000) for (int nrep_ = 0; nrep_ < NA_REP; ++nrep_) for (int nn = bx; nn < 512 + (rebal ? G : 0); nn += G) {
                int n = nn;
                if (rebal) { if (nn >= 512) { if (rgw != 4) break; n = 256 + bx - 32; } else if (nn >= 256 && rgw == 0) continue; }
                const int k = n >> 8, c = n & 255, b = c & 7, rg = (c >> 3) & 7, h = 4 * k + (c >> 6);
                const int r0 = 4 * rg, kr_lo = r0 - 4 < 0 ? 0 : r0 - 4, kr_hi = (r0 - 1 < 0 ? 0 : (r0 - 1 > 24 ? 24 : r0 - 1)) + 7, ntl = kr_hi - kr_lo + 1;
                { float* tbl = (float*)(alds + (ATT_DMA ? att::D_TBL : att::TBL_OFF)); const GAS float* rp = GIN(IN_RPB) + ((size_t)l * 8 + h) * 15 * 31;
                  for (int i = tid; i < 15 * 128; i += NWAVES * 64) { const int dr = i >> 7, dc = (i & 127) - 48; tbl[i] = (dc >= 0 && dc <= 30) ? rp[dr * 31 + dc] * 11.313708498984761f : 0.f; } }
                att::Unit u; u.Q = P + (size_t)(b * 2048 + 256 * rg) * DIN + QA_OFF + h * 128;
                u.K0 = P + (size_t)(ML + b * 256) * DIN + h * 128; u.K1 = P + (size_t)(b * 2048 + 64 * kr_lo) * DIN + h * 128; u.n0 = 4; u.dv = 1024; u.NT = (4 + ntl + 1) & ~1;
                u.O = Y + (size_t)(b * 2048 + 256 * rg) * LDH + h * 128; u.ldo = LDH; u.r0 = r0; u.kr_lo = kr_lo; u.ntl = ntl;
                if (ATT_DMA) { __syncthreads(); att::attn_dma_unit<true>(u, alds); } else att::attn_unit<true, NA_SD>(u, alds);
            }
        }
        END_PH();
        if (IN_PH() && (PH_MASK & 512)) {
            PH_VIEWS(); LI_VIEWS();
            pg8::Gemm g{Y, (const GAS bf16*)(wl + WL_PAB), LDH};
            pg8::GridOrder S; S.init(ctx_q ? MT / 256 : ML / 256, DM / 256, 0, 0, 0, 0, G, bx, 2, 1024, 1024 / 64);
            S.wgm = WGM_M1; pg8::EpiMerge1 E{P + G_OFF, DIN, Z, LDH};
            pg8::gemm_phase<pg8::EpiMerge1, pg8::GridOrder>(lds + RING_OFF, g, S, E);
            if (S.idle_last()) conv_fill(args, ws, lds, MISC, FILL_M1, 0, wave, lane);
        }
        END_PH();
        if (IN_PH() && (PH_MASK & 1024)) {
            PH_VIEWS(); LI_VIEWS();
            pg8::Gemm g{Z, (const GAS bf16*)(wl + WL_O), LDH};
            pg8::GridOrder S; if (ctx_q) S.init(ML / 256, DM / 256, 0, MC / 256, DM / 256, ML / 256, G, bx, 1, 0, DM / 64, 4, DM / 256); else S.init(ML / 256, DM / 256, 0, 0, 0, 0, G, bx, 1, 0, DM / 64);
            S.wgm = WGM_M2; pg8::EpiResid E{X, X + (size_t)ML * DM, X, modl, 5 * DM, 1.0f, ML, (GAS float*)Y};
            pg8::gemm_phase<pg8::EpiResid, pg8::GridOrder>(lds + RING_OFF, g, S, E);
        }
        END_PH();
    }
    if (IN_PH() && (PH_MASK & 2048)) {
        PH_VIEWS();
        const GAS float* g = GIN(IN_FG);
        for (int row = gw; row < ML; row += NGW) {
            const GAS f32x4* xr = (const GAS f32x4*)(X + (size_t)row * DM) + lane;
            f32x4 v[8], g8[8]; float ss = 0.f; const GAS f32x4* gp = (const GAS f32x4*)g + lane;
#pragma unroll
            for (int j = 0; j < 8; ++j) v[j] = xr[64 * j];
#pragma unroll
            for (int j = 0; j < 8; ++j) g8[j] = gp[64 * j];
#pragma unroll
            for (int j = 0; j < 8; ++j) ss += (v[j].x * v[j].x + v[j].y * v[j].y) + (v[j].z * v[j].z + v[j].w * v[j].w);
            const float rstd = 1.0f / sqrtf(wave_sum(ss) * (1.0f / DM) + EPS);
            GAS f32x4* op = (GAS f32x4*)((GAS float*)args.out + (size_t)row * DM) + lane;
#pragma unroll
            for (int j = 0; j < 8; ++j) op[64 * j] = v[j] * rstd * g8[j];
        }
    }
    END_PH();
#undef IN_PH
#undef END_PH
}
extern "C" void kernel_launch(void* const* d_in, const int* in_sizes, int n_in, void* d_out, int out_size, void* d_ws, size_t ws_size, hipStream_t stream) {
    static int grid = 0;
    if (grid == 0) {
        if (n_in != N_IN || in_sizes[0] != ML * DM || out_size != ML * DM || ws_size < WS_END) { fprintf(stderr, "kernel_launch: shape mismatch (n_in %d, in0 %d, out %d, ws %zu < %zu); nothing launched\n", n_in, n_in > 0 ? in_sizes[0] : -1, out_size, ws_size, (size_t)WS_END); grid = -1; return; }
        int dev = 0, cus = 0, per_cu = 0;
        if (hipGetDevice(&dev) != hipSuccess || hipDeviceGetAttribute(&cus, hipDeviceAttributeMultiprocessorCount, dev) != hipSuccess) { fprintf(stderr, "kernel_launch: device query failed\n"); grid = -1; return; }
        if (hipFuncSetAttribute((const void*)mega_fwd, hipFuncAttributeMaxDynamicSharedMemorySize, LDS_BYTES) != hipSuccess) { fprintf(stderr, "kernel_launch: hipFuncSetAttribute failed\n"); grid = -1; return; }
        if (hipOccupancyMaxActiveBlocksPerMultiprocessor(&per_cu, (const void*)mega_fwd, NWAVES * 64, LDS_BYTES) != hipSuccess || per_cu < 1)
            fprintf(stderr, "kernel_launch: note: occupancy query reports %d workgroups per CU\n", per_cu);
        (void)hipGetLastError();
        grid = cus;
    }
    if (grid < 0) return;
    if (hipMemsetAsync((char*)d_ws + WS_CTL, 0, CTL_ZERO_BYTES, stream) != hipSuccess) { fprintf(stderr, "kernel_launch: memset failed\n"); return; }
    Args a{};
    for (int i = 0; i < N_IN; ++i) a.in[i] = (const float*)d_in[i];
    a.out = (float*)d_out; a.ws = (unsigned char*)d_ws;
#ifdef DBG_CHECK
    dbg_run(a, grid, stream);
#else
#ifndef MK_PER_PHASE
    a.ph_lo = 0; a.ph_hi = N_PHASES;
    hipLaunchKernelGGL(mega_fwd, dim3(grid), dim3(NWAVES * 64), LDS_BYTES, stream, a);
#else
    for (int p = 0; p < N_PHASES; ++p) { a.ph_lo = p; a.ph_hi = p + 1; hipLaunchKernelGGL(mega_fwd, dim3(grid), dim3(NWAVES * 64), LDS_BYTES, stream, a); }
#endif
    const hipError_t le = hipPeekAtLastError();
    if (le != hipSuccess) fprintf(stderr, "kernel_launch: launch failed: %s\n", hipGetErrorName(le));
#endif
}
```
